# Optimizing an MI355X kernel written in HIP

```python
import jax, jax.numpy as jnp
from jax import lax
import numpy as np

D_MODEL = 1024
BATCH = 4
SEQ = 8192
DEPTH = 1
DEC_BATCH = 32
DEC_SEQ = 16
PAST_LEN = 2048

CHUNK = 64
QBLK = 128
N_HEADS = 8
QK_NOPE = 64
QK_ROPE = 32
V_DIM = 64
Q_LORA = 384
KV_LORA = 256
MLA_WIDTH = N_HEADS * V_DIM
RG_WIDTH = D_MODEL - MLA_WIDTH
RG_BLOCKS = 8
RG_BLOCK_DIM = RG_WIDTH // RG_BLOCKS
RG_CONV = 4
RG_C = 8.0
FF_DIM = 2816
FF_CONV = 3
ROPE_THETA = 10000.0
EPS = 1e-6
NEG = -1e30
SCALE = (QK_NOPE + QK_ROPE) ** -0.5
IN_COLS = Q_LORA + KV_LORA + QK_ROPE + 2 * RG_WIDTH

kernel_name = "hymba_mla_rglru_convffn_stream_step"


def rmsnorm(x, g):
    x32 = x.astype(jnp.float32)
    y = x32 * lax.rsqrt(jnp.mean(x32 * x32, axis=-1, keepdims=True) + EPS)
    return y.astype(x.dtype) * g


def rope(x, pos):
    half = QK_ROPE // 2
    inv = ROPE_THETA ** (-jnp.arange(half, dtype=jnp.float32) / half)
    ang = pos.astype(jnp.float32)[:, None] * inv[None, :]
    cos = jnp.cos(ang).astype(x.dtype)
    sin = jnp.sin(ang).astype(x.dtype)
    if x.ndim == 4:
        cos = cos[:, None, :]
        sin = sin[:, None, :]
    x1 = x[..., :half]
    x2 = x[..., half:]
    return jnp.concatenate([x1 * cos - x2 * sin, x2 * cos + x1 * sin], axis=-1)


def causal_dwconv(x, buf, w, b):
    width = w.shape[0]
    t = x.shape[1]
    xp = jnp.concatenate([buf.astype(x.dtype), x], axis=1)
    out = b
    for k in range(width):
        out = out + xp[:, k:k + t] * w[k]
    return out, xp[:, xp.shape[1] - (width - 1):]


def mla_block(q_lat, q_rope, c_kv, k_rope, q_pos, k_pos):
    s = jnp.einsum("bqhr,bkr->bhqk", q_lat, c_kv) + jnp.einsum("bqhe,bke->bhqk", q_rope, k_rope)
    s = s.astype(jnp.float32) * SCALE
    mask = (k_pos[None, :] // CHUNK) <= (q_pos[:, None] // CHUNK)
    s = jnp.where(mask[None, None], s, NEG)
    p = jax.nn.softmax(s, axis=-1).astype(c_kv.dtype)
    return jnp.einsum("bhqk,bkr->bqhr", p, c_kv)


def mla_attend(q_lat, q_rope, c_kv, k_rope, q_pos, k_pos):
    b, t = q_lat.shape[0], q_lat.shape[1]
    if t > QBLK and t % QBLK == 0:
        nb = t // QBLK
        ql = jnp.moveaxis(q_lat.reshape(b, nb, QBLK, N_HEADS, KV_LORA), 1, 0)
        qr = jnp.moveaxis(q_rope.reshape(b, nb, QBLK, N_HEADS, QK_ROPE), 1, 0)
        qp = q_pos.reshape(nb, QBLK)

        def one_block(args):
            a, r, p = args
            return mla_block(a, r, c_kv, k_rope, p, k_pos)

        o = lax.map(one_block, (ql, qr, qp))
        return jnp.moveaxis(o, 0, 1).reshape(b, t, N_HEADS, KV_LORA)
    return mla_block(q_lat, q_rope, c_kv, k_rope, q_pos, k_pos)


def linear_scan(a, u, h0):
    u = u.at[:, 0].add(a[:, 0] * h0)

    def comb(l, r):
        al, ul = l
        ar, ur = r
        return al * ar, ar * ul + ur

    _, h = lax.associative_scan(comb, (a, u), axis=1)
    return h


def layer(x, pos, past_ckv, past_krope, past_pos, h0, rg_buf, ff_buf, p):
    (norm_mix_g, w_in, q_norm_g, w_uq, kv_norm_g, w_uk, w_uv, w_rg_conv, b_rg_conv,
     w_rg_a, b_rg_a, w_rg_i, b_rg_i, rg_lambda, w_out, norm_ffn_g, w_ffn_up,
     w_ffn_conv, b_ffn_conv, w_ffn_down) = p
    b, t, _ = x.shape
    xn = rmsnorm(x, norm_mix_g)
    proj = xn @ w_in
    o1 = Q_LORA
    o2 = o1 + KV_LORA
    o3 = o2 + QK_ROPE
    o4 = o3 + RG_WIDTH
    c_q = proj[..., :o1]
    c_kv_raw = proj[..., o1:o2]
    k_rope_raw = proj[..., o2:o3]
    rg_x = proj[..., o3:o4]
    rg_gate = proj[..., o4:]

    q = jnp.einsum("btr,rhd->bthd", rmsnorm(c_q, q_norm_g), w_uq)
    q_nope = q[..., :QK_NOPE]
    q_rope = rope(q[..., QK_NOPE:], pos)
    c_kv = rmsnorm(c_kv_raw, kv_norm_g)
    k_rope = rope(k_rope_raw, pos)
    if past_ckv is None:
        all_ckv, all_krope, k_pos = c_kv, k_rope, pos
    else:
        all_ckv = jnp.concatenate([past_ckv.astype(c_kv.dtype), c_kv], axis=1)
        all_krope = jnp.concatenate([past_krope.astype(k_rope.dtype), k_rope], axis=1)
        k_pos = jnp.concatenate([past_pos, pos])
    q_lat = jnp.einsum("bthn,rhn->bthr", q_nope, w_uk)
    o_lat = mla_attend(q_lat, q_rope, all_ckv, all_krope, pos, k_pos)
    o_mla = jnp.einsum("bthr,rhv->bthv", o_lat, w_uv).reshape(b, t, MLA_WIDTH)

    xc, new_rg_buf = causal_dwconv(rg_x, rg_buf, w_rg_conv, b_rg_conv)
    xb = xc.reshape(b, t, RG_BLOCKS, RG_BLOCK_DIM)
    r = jax.nn.sigmoid(jnp.einsum("btnc,ncd->btnd", xb, w_rg_a).reshape(b, t, RG_WIDTH) + b_rg_a)
    i = jax.nn.sigmoid(jnp.einsum("btnc,ncd->btnd", xb, w_rg_i).reshape(b, t, RG_WIDTH) + b_rg_i)
    log_a = -RG_C * r.astype(jnp.float32) * jax.nn.softplus(-rg_lambda.astype(jnp.float32))
    a = jnp.exp(log_a)
    u = jnp.sqrt(-jnp.expm1(2.0 * log_a)) * (i * xc).astype(jnp.float32)
    h = linear_scan(a, u, h0.astype(jnp.float32))
    o_rg = h.astype(x.dtype) * jax.nn.gelu(rg_gate)

    x = x + jnp.concatenate([o_mla, o_rg], axis=-1) @ w_out

    up = rmsnorm(x, norm_ffn_g) @ w_ffn_up
    upc, new_ff_buf = causal_dwconv(up, ff_buf, w_ffn_conv, b_ffn_conv)
    x = x + (jax.nn.gelu(upc[..., :FF_DIM]) * upc[..., FF_DIM:]) @ w_ffn_down
    return x, c_kv, k_rope, h[:, -1].astype(h0.dtype), new_rg_buf, new_ff_buf


def setup_inputs(seed: int = 0) -> dict:
    key = jax.random.key(seed)
    ks = jax.random.split(key, 32)

    def nrm(k, shape, scale):
        return jax.random.normal(k, shape, jnp.float32) * scale

    u = jax.random.uniform(ks[20], (DEPTH, RG_WIDTH), jnp.float32, 0.9, 0.999)
    s = u ** (1.0 / RG_C)
    rg_lambda = jnp.log(s / (1.0 - s))
    return {
        "x_prompt": nrm(ks[0], (BATCH, SEQ, D_MODEL), 1.0),
        "x_sample": nrm(ks[1], (DEC_BATCH, DEC_SEQ, D_MODEL), 1.0),
        "cache_ckv": nrm(ks[2], (DEPTH, DEC_BATCH, PAST_LEN, KV_LORA), 1.0),
        "cache_krope": nrm(ks[3], (DEPTH, DEC_BATCH, PAST_LEN, QK_ROPE), 1.0),
        "state_rg_h": nrm(ks[4], (DEPTH, DEC_BATCH, RG_WIDTH), 0.5),
        "state_rg_conv": nrm(ks[5], (DEPTH, DEC_BATCH, RG_CONV - 1, RG_WIDTH), 1.0),
        "state_ffn_conv": nrm(ks[6], (DEPTH, DEC_BATCH, FF_CONV - 1, 2 * FF_DIM), 1.0),
        "norm_mix_g": 1.0 + nrm(ks[7], (DEPTH, D_MODEL), 0.02),
        "w_in": nrm(ks[8], (DEPTH, D_MODEL, IN_COLS), D_MODEL ** -0.5),
        "q_norm_g": 1.0 + nrm(ks[9], (DEPTH, Q_LORA), 0.02),
        "w_uq": nrm(ks[10], (DEPTH, Q_LORA, N_HEADS, QK_NOPE + QK_ROPE), Q_LORA ** -0.5),
        "kv_norm_g": 1.0 + nrm(ks[11], (DEPTH, KV_LORA), 0.02),
        "w_uk": nrm(ks[12], (DEPTH, KV_LORA, N_HEADS, QK_NOPE), KV_LORA ** -0.5),
        "w_uv": nrm(ks[13], (DEPTH, KV_LORA, N_HEADS, V_DIM), KV_LORA ** -0.5),
        "w_rg_conv": nrm(ks[14], (DEPTH, RG_CONV, RG_WIDTH), RG_CONV ** -0.5),
        "b_rg_conv": nrm(ks[15], (DEPTH, RG_WIDTH), 0.02),
        "w_rg_a": nrm(ks[16], (DEPTH, RG_BLOCKS, RG_BLOCK_DIM, RG_BLOCK_DIM), RG_BLOCK_DIM ** -0.5),
        "b_rg_a": nrm(ks[17], (DEPTH, RG_WIDTH), 0.02),
        "w_rg_i": nrm(ks[18], (DEPTH, RG_BLOCKS, RG_BLOCK_DIM, RG_BLOCK_DIM), RG_BLOCK_DIM ** -0.5),
        "b_rg_i": nrm(ks[19], (DEPTH, RG_WIDTH), 0.02),
        "rg_lambda": rg_lambda,
        "w_out": nrm(ks[21], (DEPTH, D_MODEL, D_MODEL), D_MODEL ** -0.5),
        "norm_ffn_g": 1.0 + nrm(ks[22], (DEPTH, D_MODEL), 0.02),
        "w_ffn_up": nrm(ks[23], (DEPTH, D_MODEL, 2 * FF_DIM), D_MODEL ** -0.5),
        "w_ffn_conv": nrm(ks[24], (DEPTH, FF_CONV, 2 * FF_DIM), FF_CONV ** -0.5),
        "b_ffn_conv": nrm(ks[25], (DEPTH, 2 * FF_DIM), 0.02),
        "w_ffn_down": nrm(ks[26], (DEPTH, FF_DIM, D_MODEL), FF_DIM ** -0.5),
        "final_norm_g": 1.0 + nrm(ks[27], (D_MODEL,), 0.02),
    }


def reference(x_prompt, x_sample, cache_ckv, cache_krope, state_rg_h, state_rg_conv, state_ffn_conv,
              norm_mix_g, w_in, q_norm_g, w_uq, kv_norm_g, w_uk, w_uv, w_rg_conv, b_rg_conv,
              w_rg_a, b_rg_a, w_rg_i, b_rg_i, rg_lambda, w_out, norm_ffn_g, w_ffn_up,
              w_ffn_conv, b_ffn_conv, w_ffn_down, final_norm_g):
    bp, sp = x_prompt.shape[0], x_prompt.shape[1]
    sd = x_sample.shape[1]
    past = cache_ckv.shape[2]
    pos_p = jnp.arange(sp, dtype=jnp.int32)
    past_pos = jnp.arange(past, dtype=jnp.int32)
    pos_s = past + jnp.arange(sd, dtype=jnp.int32)
    yp, ys = x_prompt, x_sample
    pc, pk, ph, prb, pfb = [], [], [], [], []
    sc, sk, sh, srb, sfb = [], [], [], [], []
    for l in range(DEPTH):
        p = (norm_mix_g[l], w_in[l], q_norm_g[l], w_uq[l], kv_norm_g[l], w_uk[l], w_uv[l],
             w_rg_conv[l], b_rg_conv[l], w_rg_a[l], b_rg_a[l], w_rg_i[l], b_rg_i[l], rg_lambda[l],
             w_out[l], norm_ffn_g[l], w_ffn_up[l], w_ffn_conv[l], b_ffn_conv[l], w_ffn_down[l])
        h0_p = jnp.zeros((bp, RG_WIDTH), state_rg_h.dtype)
        rb_p = jnp.zeros((bp, RG_CONV - 1, RG_WIDTH), x_prompt.dtype)
        fb_p = jnp.zeros((bp, FF_CONV - 1, 2 * FF_DIM), x_prompt.dtype)
        yp, c1, k1, h1, r1, f1 = layer(yp, pos_p, None, None, None, h0_p, rb_p, fb_p, p)
        ys, c2, k2, h2, r2, f2 = layer(ys, pos_s, cache_ckv[l], cache_krope[l], past_pos,
                                       state_rg_h[l], state_rg_conv[l], state_ffn_conv[l], p)
        pc.append(c1); pk.append(k1); ph.append(h1); prb.append(r1); pfb.append(f1)
        sc.append(c2); sk.append(k2); sh.append(h2); srb.append(r2); sfb.append(f2)
    y_prompt = rmsnorm(yp, final_norm_g)
    y_sample = rmsnorm(ys, final_norm_g)
    p_ckv = jnp.stack(pc)
    p_krope = jnp.stack(pk)
    p_rg_h = jnp.stack(ph)
    p_rg_conv = jnp.stack(prb)
    p_ffn_conv = jnp.stack(pfb)
    s_ckv = jnp.stack(sc)
    s_krope = jnp.stack(sk)
    s_rg_h = jnp.stack(sh)
    s_rg_conv = jnp.stack(srb)
    s_ffn_conv = jnp.stack(sfb)
    return (y_prompt, y_sample, p_ckv, p_krope, p_rg_h, p_rg_conv, p_ffn_conv,
            s_ckv, s_krope, s_rg_h, s_rg_conv, s_ffn_conv)
```

```cpp
#include <hip/hip_runtime.h>
#include <hip/hip_cooperative_groups.h>
#include <cstdio>
#include <cstdint>
namespace cg = cooperative_groups;

#define LAS __attribute__((address_space(3)))
typedef unsigned short bf16_t;
typedef short bf16x8 __attribute__((ext_vector_type(8)));
typedef short s16x4 __attribute__((ext_vector_type(4)));
typedef float f32x2 __attribute__((ext_vector_type(2)));
typedef float f32x4 __attribute__((ext_vector_type(4)));
typedef float f32x16 __attribute__((ext_vector_type(16)));
typedef unsigned u32x2 __attribute__((ext_vector_type(2)));
typedef unsigned u32x4 __attribute__((ext_vector_type(4)));

constexpr int DM = 1024, NB = 4, SEQ = 8192, DB = 32, DS = 16, PAST = 2048;
constexpr int MP = NB * SEQ;
constexpr int MS = DB * DS;
constexpr int MT = MP + MS;
constexpr int QL = 384, KVL = 256, ROPE = 32, RGW = 512, FF = 2816, FF2 = 5632;
constexpr int NIN = 1792;
constexpr int NQ = 768;
constexpr float EPS = 1e-6f;
constexpr float QSCALE = 0.10206207261596577f * 1.4426950408889634f;
constexpr int C_CQ = 0, C_CKV = 384, C_RGX = 640, C_RGG = 1152, C_KR = 1664;

constexpr size_t O_Y = 0, O_PCKV = 34078720, O_PKR = 42467328, O_PRGH = 43515904, O_PRGC = 43517952, O_PFFC = 43524096,
                 O_SCKV = 43569152, O_SKR = 43700224, O_SRGH = 43716608, O_SRGC = 43732992, O_SFFC = 43782144;

constexpr size_t MiB = 1u << 20;
constexpr size_t WS_SP = 0;
constexpr size_t WS_BAR = 16 * 1024;
constexpr size_t WS_SA = 64 * 1024;
constexpr size_t WS_SU = WS_SA + 512 * 1024;
constexpr size_t WS_ROPE = 2 * MiB;
constexpr size_t WS_SSQ2 = 3 * MiB;
constexpr size_t WS_SSQ3 = 6 * MiB;
constexpr size_t WS_WIN = 9 * MiB;
constexpr size_t WS_WUQ = 13 * MiB;
constexpr size_t WS_WKV = 14 * MiB;
constexpr size_t WS_WRG = 15 * MiB;
constexpr size_t WS_WOUT = 16 * MiB;
constexpr size_t WS_WUP = 18 * MiB;
constexpr size_t WS_WDN = 29 * MiB;
constexpr size_t WS_S1 = 36 * MiB;
constexpr size_t WS_XN = WS_S1;
constexpr size_t WS_PROJ = WS_S1 + 66 * MiB;
constexpr size_t WS_KV = WS_S1;
constexpr size_t WS_PO = WS_S1 + 100 * MiB;
constexpr size_t WS_PM = WS_S1 + 140 * MiB;
constexpr size_t WS_PL = WS_S1 + 141 * MiB;
constexpr size_t WS_ACT = WS_S1;
constexpr size_t WS_S2 = WS_S1 + 200 * MiB;
constexpr size_t WS_CQN = WS_S2;
constexpr size_t WS_XC = WS_S2 + 25 * MiB;
constexpr size_t WS_CKVN = WS_S2 + 58 * MiB;
constexpr size_t WS_CAT = WS_S2;
constexpr size_t WS_HT = WS_S2 + 66 * MiB;
constexpr size_t WS_UPS = WS_S2 + 78 * MiB;
constexpr size_t WS_S3 = WS_S2 + 108 * MiB;
constexpr size_t WS_LA = WS_S3;
constexpr size_t WS_KR = WS_S3 + 65 * MiB;
constexpr size_t WS_X1B = WS_S3;
constexpr size_t WS_PART = WS_S2;
constexpr size_t WS_END = WS_S3 + 72 * MiB;
constexpr size_t YS_Q = 0;
constexpr size_t YS_GG = 50 * MiB;
constexpr size_t YS_U = 83 * MiB;

#ifndef P3SEL
#define P3SEL 7
#endif
#ifndef SAMPLE_REP
#define SAMPLE_REP 1
#endif
#ifndef RG_REP
#define RG_REP 1
#endif
#ifndef DUPMASK
#define DUPMASK 0
#endif
#ifndef PHMASK
#define PHMASK 0x7ff
#endif
constexpr int LDS_STAGE = 131072, LDS_HALO = 131072, LDS_BYTES = 147456;

__device__ __forceinline__ unsigned f2bf(float f) { unsigned u = __builtin_bit_cast(unsigned, f); return (u + 0x7fffu + ((u >> 16) & 1u)) >> 16; }
__device__ __forceinline__ unsigned pk2(float lo, float hi) { return f2bf(lo) | (f2bf(hi) << 16); }
__device__ __forceinline__ float bflo(unsigned w) { return __builtin_bit_cast(float, w << 16); }
__device__ __forceinline__ float bfhi(unsigned w) { return __builtin_bit_cast(float, w & 0xffff0000u); }
__device__ __forceinline__ float bf2f(bf16_t h) { return __builtin_bit_cast(float, (unsigned)h << 16); }
__device__ __forceinline__ float wave_sum(float v) {
#pragma unroll
    for (int o = 1; o < 64; o <<= 1) v += __shfl_xor(v, o);
    return v;
}
__device__ __forceinline__ float fexp(float x) { return __builtin_amdgcn_exp2f(x * 1.4426950408889634f); }
__device__ __forceinline__ float sigmoidf_(float x) { return __builtin_amdgcn_rcpf(1.0f + __builtin_amdgcn_exp2f(-1.4426950408889634f * x)); }
__device__ __forceinline__ float gelu_tanh(float x) {
    const float t = x * (1.0f + 0.044715f * x * x);
    return x * __builtin_amdgcn_rcpf(1.0f + __builtin_amdgcn_exp2f(-2.3022082f * t));
}
__device__ __forceinline__ int tok_pos(int r) { return r < MP ? (r & (SEQ - 1)) : PAST + ((r - MP) & (DS - 1)); }

namespace pg8 {
constexpr int BM = 256, BK = 64, HALF = 128, HTB = HALF * BK * 2, STAGE_BYTES = 8 * HTB, NXCD = 8, WGM = 8;
__host__ __device__ __forceinline__ int lds_byte(int r, int c) { const int st = (r >> 4) * 2 + (c >> 5), rr = r & 15, cc = c & 31, ob = rr * 64 + cc * 2; return st * 1024 + (ob ^ (((ob >> 9) & 1) << 5)); }
__host__ __device__ __forceinline__ void stage_rc(int b, int& R, int& C) { const int st = b / 1024, sb = b % 1024, swz = sb ^ (((sb >> 9) & 1) << 5); R = (st >> 1) * 16 + swz / 64; C = (st & 1) * 32 + (swz % 64) / 2; }
__host__ __device__ __forceinline__ int perm32(int rho) { const int n = rho >> 4, i = rho & 15; return 8 * (i >> 2) + 4 * n + (i & 3); }
struct Unit { int pm, pn, kofs, nt; };
struct Gemm { const bf16_t* A; const bf16_t* Bt; int lda, ldb; };
struct StaticOrder {
    int nM, nN, nwg, G, c, nt;
    __host__ __device__ void init(int M, int N, int K, int G_, int c_) { nM = M / BM; nN = N / BM; nwg = nM * nN; G = G_; c = c_; nt = K / BK; }
    __host__ __device__ void map(int wgid, Unit& u) const {
        { const int q = nwg / NXCD, r = nwg % NXCD, xcd = wgid % NXCD, off = wgid / NXCD; wgid = (xcd < r ? xcd * (q + 1) : r * (q + 1) + (xcd - r) * q) + off; }
        const int nig = WGM * nN, gid = wgid / nig, fm = gid * WGM, gsz = (nM - fm) < WGM ? (nM - fm) : WGM;
        u.pm = fm + ((wgid % nig) % gsz); u.pn = (wgid % nig) / gsz; u.kofs = 0; u.nt = nt;
    }
    __host__ __device__ bool next(int i, Unit& u) const {
        const long L = (long)i * G + c; if (L >= nwg) return false;
        map((int)L, u); return true;
    }
};
struct RgOrder {
    StaticOrder S;
    __host__ __device__ bool next(int i, Unit& u) const { if (!S.next(i, u)) return false; u.kofs = 128 * u.pn; int n2 = 2; asm volatile("" : "+s"(n2)); u.nt = n2; return true; }
};
struct DownOrder {
    StaticOrder S;
    __host__ __device__ bool next(int i, Unit& u) const {
        const long L = (long)i * S.G + S.c;
        if (L < S.nwg) { S.map((int)L, u); return true; }
        const int v = (int)(L - S.nwg); if (v >= 88) return false;
        const int ks = v % 11, t = v / 11; u.pm = S.nM + (t >> 2); u.pn = t & 3; u.kofs = ks * 256; u.nt = 4; return true;
    }
};
struct UpOrder {
    StaticOrder S;
    __host__ __device__ bool next(int i, Unit& u) const {
        const long L = (long)i * S.G + S.c;
        if (L < S.nwg) { S.map((int)L, u); return true; }
        const int v = (int)(L - S.nwg); if (v >= 176) return false;
        const int ks = v & 3, t = v >> 2; u.pm = S.nM + t / 22; u.pn = t % 22; u.kofs = ks * 256; u.nt = 4; return true;
    }
};
typedef __bf16 bf16x2_t __attribute__((ext_vector_type(2)));
__device__ __forceinline__ unsigned cvt_pk_bf16(float lo, float hi) { const f32x2 v = {lo, hi}; return __builtin_bit_cast(unsigned, __builtin_convertvector(v, bf16x2_t)); }

typedef f32x4 Acc[2][2][4][2];

template <class Epi, class Sched, bool ALIGN_EPI = true>
__device__ __forceinline__ void gemm_phase(LAS unsigned char* lds, const Gemm g, const Sched& S, const Epi& E) {
    int tid = threadIdx.x; asm volatile("" : "+v"(tid));
    const int wid = __builtin_amdgcn_readfirstlane(tid >> 6), lane = tid & 63, wr = wid >> 2, wc = wid & 3, fr = lane & 15, fq = lane >> 4;
    unsigned voffA[2], voffB[2];
#pragma unroll
    for (int i = 0; i < 2; ++i) { int R, C; stage_rc(tid * 16 + i * 8192, R, C); const int Rb = Epi::PERM ? ((R & ~31) + perm32(R & 31)) : R;
        voffA[i] = (unsigned)(R * g.lda + C) * 2u; voffB[i] = (unsigned)(Rb * g.ldb + C) * 2u; }
    const size_t kstep = (size_t)(BK * 2);
    const size_t hstepA = (size_t)HALF * g.lda * 2, hstepB = (size_t)HALF * g.ldb * 2;
    const unsigned ldsw = (unsigned)wid * 1024u;
    const int aoff = lds_byte(wr * 64 + fr, fq * 8), boff = lds_byte(wc * 32 + fr, fq * 8);
#define PG8_SA(b, h) (((b) * 2 + (h)) * HTB)
#define PG8_SB(b, h) ((4 + (b) * 2 + (h)) * HTB)
#define PG8_STAGE(bufoff, gbase, voff) do { _Pragma("unroll") for (int _i = 0; _i < 2; ++_i) \
        __builtin_amdgcn_global_load_lds((const unsigned*)((const char*)(gbase) + (voff)[_i]), (LAS unsigned*)(lds + (bufoff) + ldsw + _i * 8192), 16, 0, 0); } while (0)
#define PG8_LDA(dst, b, h) do { _Pragma("unroll") for (int m = 0; m < 4; ++m) _Pragma("unroll") for (int k = 0; k < 2; ++k) dst[m][k] = *(const LAS bf16x8*)(lds + PG8_SA(b, h) + aoff + m * 2048 + k * 1024); } while (0)
#define PG8_LDB(dst, b, h) do { _Pragma("unroll") for (int n = 0; n < 2; ++n) _Pragma("unroll") for (int k = 0; k < 2; ++k) dst[n][k] = *(const LAS bf16x8*)(lds + PG8_SB(b, h) + boff + n * 2048 + k * 1024); } while (0)
#define PG8_MMA(ai, bj, At, Bt) do { __builtin_amdgcn_s_setprio(1); _Pragma("unroll") for (int m = 0; m < 4; ++m) _Pragma("unroll") for (int n = 0; n < 2; ++n) _Pragma("unroll") for (int k = 0; k < 2; ++k) \
        acc[ai][bj][m][n] = __builtin_amdgcn_mfma_f32_16x16x32_bf16(Bt[n][k], At[m][k], acc[ai][bj][m][n], 0, 0, 0); __builtin_amdgcn_s_setprio(0); } while (0)
#define PG8_WAIT_V(n) asm volatile("s_waitcnt vmcnt(" #n ")" ::: "memory")
#define PG8_WAIT_L(n) asm volatile("s_waitcnt lgkmcnt(" #n ")" ::: "memory")
#define PG8_BAR __builtin_amdgcn_s_barrier()
#define PG8_SCHED __builtin_amdgcn_sched_barrier(0)
    Unit cur, nxt; int ui = 0;
    if (!S.next(0, cur)) return;
    Acc acc;
#pragma unroll
    for (int a = 0; a < 2; ++a)
#pragma unroll
        for (int b = 0; b < 2; ++b)
#pragma unroll
            for (int m = 0; m < 4; ++m)
#pragma unroll
                for (int n = 0; n < 2; ++n) acc[a][b][m][n] = (f32x4){0.f, 0.f, 0.f, 0.f};
    bf16x8 At[4][2], B0[2][2], B1[2][2];
    const char* cA = (const char*)g.A + ((size_t)cur.pm * 2 * hstepA + (size_t)cur.kofs * 2); const char* cB = (const char*)g.Bt + ((size_t)cur.pn * 2 * hstepB + (size_t)cur.kofs * 2);
    PG8_STAGE(PG8_SB(0, 0), cB, voffB); PG8_STAGE(PG8_SB(0, 1), cB + hstepB, voffB); PG8_STAGE(PG8_SA(0, 0), cA, voffA); PG8_STAGE(PG8_SA(0, 1), cA + hstepA, voffA);
    if (wr == 1) PG8_BAR;
    PG8_WAIT_V(2); PG8_BAR;
    PG8_STAGE(PG8_SB(1, 0), cB + kstep, voffB); PG8_STAGE(PG8_SA(1, 0), cA + kstep, voffA); PG8_STAGE(PG8_SB(1, 1), cB + hstepB + kstep, voffB);
    PG8_WAIT_V(6); PG8_BAR;
    for (;;) {
        const bool has_next = S.next(ui + 1, nxt);
        const char* nA = has_next ? (const char*)g.A + ((size_t)nxt.pm * 2 * hstepA + (size_t)nxt.kofs * 2) : cA; const char* nB = has_next ? (const char*)g.Bt + ((size_t)nxt.pn * 2 * hstepB + (size_t)nxt.kofs * 2) : cB;
        const int nt = cur.nt;
        for (int t = 0; t < nt; t += 2) {
            const bool last = (t == nt - 2);
            const char* a1 = cA + (size_t)(t + 1) * kstep;
            const char* a2 = last ? nA : cA + (size_t)(t + 2) * kstep; const char* b2 = last ? nB : cB + (size_t)(t + 2) * kstep;
            const char* a3 = a2 + kstep; const char* b3 = b2 + kstep;
            PG8_LDB(B0, 0, 0); PG8_LDB(B1, 0, 1); PG8_SCHED; PG8_LDA(At, 0, 0); PG8_STAGE(PG8_SA(1, 1), a1 + hstepA, voffA);
            PG8_WAIT_V(8); PG8_WAIT_L(0); PG8_BAR; PG8_MMA(0, 0, At, B0); PG8_MMA(0, 1, At, B1); PG8_BAR; PG8_SCHED;
            PG8_LDA(At, 0, 1); PG8_STAGE(PG8_SB(0, 0), b2, voffB); PG8_STAGE(PG8_SB(0, 1), b2 + hstepB, voffB); PG8_STAGE(PG8_SA(0, 0), a2, voffA);
            PG8_WAIT_V(8); PG8_WAIT_L(0); PG8_BAR; PG8_MMA(1, 0, At, B0); PG8_MMA(1, 1, At, B1); PG8_BAR; PG8_SCHED;
            PG8_LDB(B0, 1, 0); PG8_LDB(B1, 1, 1); PG8_SCHED; PG8_LDA(At, 1, 0); PG8_STAGE(PG8_SA(0, 1), a2 + hstepA, voffA);
            PG8_WAIT_V(8); PG8_WAIT_L(0); PG8_BAR; PG8_MMA(0, 0, At, B0); PG8_MMA(0, 1, At, B1); PG8_BAR; PG8_SCHED;
            PG8_LDA(At, 1, 1); PG8_STAGE(PG8_SB(1, 0), b3, voffB); PG8_STAGE(PG8_SB(1, 1), b3 + hstepB, voffB); PG8_STAGE(PG8_SA(1, 0), a3, voffA);
            PG8_WAIT_V(8); PG8_WAIT_L(0); PG8_BAR; PG8_MMA(1, 0, At, B0); PG8_MMA(1, 1, At, B1); PG8_BAR; PG8_SCHED;
        }
        if constexpr (ALIGN_EPI) { if (wr == 0) PG8_BAR; }
        { int fr2 = fr, fq2 = fq; asm volatile("" : "+v"(fr2), "+v"(fq2)); E(acc, cur, wr, wc, fr2, fq2); }
        if (!has_next) break;
#pragma unroll
        for (int a = 0; a < 2; ++a)
#pragma unroll
            for (int b = 0; b < 2; ++b)
#pragma unroll
                for (int m = 0; m < 4; ++m)
#pragma unroll
                    for (int n = 0; n < 2; ++n) acc[a][b][m][n] = (f32x4){0.f, 0.f, 0.f, 0.f};
        cur = nxt; cA = nA; cB = nB; ++ui;
        if constexpr (ALIGN_EPI) { if (wr == 1) PG8_BAR; }
    }
    PG8_WAIT_V(0);
    if constexpr (!ALIGN_EPI) { if (wr == 0) PG8_BAR; }
    PG8_BAR;
#undef PG8_SA
#undef PG8_SB
#undef PG8_STAGE
#undef PG8_LDA
#undef PG8_LDB
#undef PG8_MMA
#undef PG8_WAIT_V
#undef PG8_WAIT_L
#undef PG8_BAR
#undef PG8_SCHED
}

template <bool KVMAP> struct EpiStore {
    static constexpr bool PERM = true;
    bf16_t* O; int ldc;
    __device__ __forceinline__ void operator()(Acc& acc, const Unit& u, int wr, int wc, int fr, int fq) const {
        const int row0 = u.pm * BM + wr * 64 + fr; const int col0 = u.pn * BM + wc * 32 + 8 * fq;
#pragma unroll
        for (int ai = 0; ai < 2; ++ai)
#pragma unroll
            for (int m = 0; m < 4; ++m) {
                int row = row0 + ai * HALF + m * 16;
                bf16_t* rowp = O + (size_t)row * ldc + col0;
#pragma unroll
                for (int bj = 0; bj < 2; ++bj) { const f32x4 v0 = acc[ai][bj][m][0], v1 = acc[ai][bj][m][1];
                    u32x4 w; w.x = cvt_pk_bf16(v0[0], v0[1]); w.y = cvt_pk_bf16(v0[2], v0[3]); w.z = cvt_pk_bf16(v1[0], v1[1]); w.w = cvt_pk_bf16(v1[2], v1[3]);
                    *(u32x4*)(rowp + bj * HALF) = w; } }
    }
};
struct EpiQ {
    static constexpr bool PERM = false;
    bf16_t* Q; const f32x2* rope;
    __device__ __forceinline__ void operator()(Acc& acc, const Unit& u, int wr, int wc, int fr, int fq) const {
        const int row0 = u.pm * BM + wr * 64 + fr;
#pragma unroll
        for (int ai = 0; ai < 2; ++ai)
#pragma unroll
            for (int m = 0; m < 4; ++m) {
                const int row = row0 + ai * HALF + m * 16; const int pos = tok_pos(row);
                const f32x4* cs = (const f32x4*)(rope + (size_t)pos * 16 + 4 * fq);
#pragma unroll
                for (int bj = 0; bj < 2; ++bj) {
                    const int g = u.pn * 8 + bj * 4 + wc;
                    f32x4 v0 = acc[ai][bj][m][0], v1 = acc[ai][bj][m][1];
                    if (g % 3 == 2) { const f32x4 c01 = cs[0], c23 = cs[1];
                        const float c[4] = {c01[0], c01[2], c23[0], c23[2]}, s[4] = {c01[1], c01[3], c23[1], c23[3]};
#pragma unroll
                        for (int e = 0; e < 4; ++e) { const float x1 = v0[e], x2 = v1[e]; v0[e] = x1 * c[e] - x2 * s[e]; v1[e] = x2 * c[e] + x1 * s[e]; } }
                    v0 = v0 * QSCALE; v1 = v1 * QSCALE;
                    bf16_t* p = Q + (size_t)row * NQ + u.pn * BM + bj * HALF + wc * 32 + 4 * fq;
                    u32x2 w0, w1; w0.x = cvt_pk_bf16(v0[0], v0[1]); w0.y = cvt_pk_bf16(v0[2], v0[3]); w1.x = cvt_pk_bf16(v1[0], v1[1]); w1.y = cvt_pk_bf16(v1[2], v1[3]);
                    *(u32x2*)p = w0; *(u32x2*)(p + 16) = w1; }
                asm volatile("" ::: "memory"); }
    }
};
struct EpiRG {
    static constexpr bool PERM = true;
    const bf16_t* xc; const float* ba; const float* bi; const float* sp; _Float16* la; bf16_t* uo;
    __device__ __forceinline__ void operator()(Acc& acc, const Unit& u, int wr, int wc, int fr, int fq) const {
        const int row0 = u.pm * BM + wr * 64 + fr; const int ch0 = u.pn * HALF + wc * 32 + 8 * fq;
#pragma unroll
        for (int n = 0; n < 2; ++n) {
            const f32x4 vba = *(const f32x4*)(ba + ch0 + 4 * n), vbi = *(const f32x4*)(bi + ch0 + 4 * n), vsp = *(const f32x4*)(sp + ch0 + 4 * n);
#pragma unroll
            for (int ai = 0; ai < 2; ++ai) {
                u32x2 xwv[4];
#pragma unroll
                for (int m = 0; m < 4; ++m) xwv[m] = *(const u32x2*)(xc + (size_t)(row0 + ai * HALF + m * 16) * RGW + ch0 + 4 * n);
#pragma unroll
                for (int m = 0; m < 4; ++m) {
                    const int row = row0 + ai * HALF + m * 16;
                    const u32x2 xw = xwv[m];
                    const float xv[4] = {bflo(xw.x), bfhi(xw.x), bflo(xw.y), bfhi(xw.y)};
                    f32x4 lo; float uu[4];
#pragma unroll
                    for (int e = 0; e < 4; ++e) {
                        const float r = sigmoidf_(acc[ai][0][m][n][e] + vba[e]), ig = sigmoidf_(acc[ai][1][m][n][e] + vbi[e]);
                        const float l = -8.0f * r * vsp[e];
                        lo[e] = l; uu[e] = __builtin_amdgcn_sqrtf(1.0f - __builtin_amdgcn_exp2f(2.8853900817779268f * l)) * (ig * xv[e]); }
                    { typedef _Float16 h4 __attribute__((ext_vector_type(4))); h4 lh; lh[0] = (_Float16)(lo[0] * 256.0f); lh[1] = (_Float16)(lo[1] * 256.0f); lh[2] = (_Float16)(lo[2] * 256.0f); lh[3] = (_Float16)(lo[3] * 256.0f);
                      *(h4*)(la + (size_t)row * RGW + ch0 + 4 * n) = lh; }
                    u32x2 w; w.x = cvt_pk_bf16(uu[0], uu[1]); w.y = cvt_pk_bf16(uu[2], uu[3]);
                    *(u32x2*)(uo + (size_t)row * RGW + ch0 + 4 * n) = w; }
                asm volatile("" ::: "memory"); } }
    }
};
template <bool INPLACE> struct EpiRes {
    static constexpr bool PERM = false;
    const float* xp; const float* xs; float* Y; bf16_t* xb; float* ssq;
    __device__ __forceinline__ void operator()(Acc& acc, const Unit& u, int wr, int wc, int fr, int fq) const {
        const int row0 = u.pm * BM + wr * 64 + fr; const int col0 = u.pn * BM + wc * 32 + 4 * fq;
#pragma unroll
        for (int ai = 0; ai < 2; ++ai) {
            f32x4 res[4][2][2];
#pragma unroll
            for (int m = 0; m < 4; ++m) { const int row = row0 + ai * HALF + m * 16;
                const float* rp = INPLACE ? (Y + (size_t)row * DM) : (row < MP ? xp + (size_t)row * DM : xs + (size_t)(row - MP) * DM);
#pragma unroll
                for (int bj = 0; bj < 2; ++bj)
#pragma unroll
                    for (int n = 0; n < 2; ++n) res[m][bj][n] = __builtin_nontemporal_load((const f32x4*)(rp + col0 + bj * HALF + n * 16)); }
#pragma unroll
            for (int m = 0; m < 4; ++m) { const int row = row0 + ai * HALF + m * 16; float ss = 0.f;
#pragma unroll
                for (int bj = 0; bj < 2; ++bj)
#pragma unroll
                    for (int n = 0; n < 2; ++n) { const int col = col0 + bj * HALF + n * 16;
                        const f32x4 v = res[m][bj][n] + acc[ai][bj][m][n];
                        if (INPLACE) *(f32x4*)(Y + (size_t)row * DM + col) = v;
                        if (!INPLACE) { u32x2 w; w.x = cvt_pk_bf16(v[0], v[1]); w.y = cvt_pk_bf16(v[2], v[3]); *(u32x2*)(xb + (size_t)row * DM + col) = w; }
                        ss += (v[0] * v[0] + v[1] * v[1]) + (v[2] * v[2] + v[3] * v[3]); }
                ss += __shfl_xor(ss, 16); ss += __shfl_xor(ss, 32);
                if (fq == 0) ssq[(size_t)row * 16 + u.pn * 4 + wc] = ss; }
            asm volatile("" ::: "memory"); }
    }
};
struct EpiDown {
    static constexpr bool PERM = false;
    float* Y; float* PART; const bf16_t* xb;
    __device__ __forceinline__ void operator()(Acc& acc, const Unit& u, int wr, int wc, int fr, int fq) const {
        const int row0 = u.pm * BM + wr * 64 + fr; const int col0 = u.pn * BM + wc * 32 + 4 * fq;
        if (u.pm >= MP / BM) {
            float* pb = PART + (size_t)(u.kofs >> 8) * MS * DM;
#pragma unroll
            for (int ai = 0; ai < 2; ++ai)
#pragma unroll
                for (int m = 0; m < 4; ++m) { float* rp = pb + (size_t)(row0 + ai * HALF + m * 16 - MP) * DM + col0;
#pragma unroll
                    for (int bj = 0; bj < 2; ++bj)
#pragma unroll
                        for (int n = 0; n < 2; ++n) *(f32x4*)(rp + bj * HALF + n * 16) = acc[ai][bj][m][n]; }
            return; }
#pragma unroll
        for (int ai = 0; ai < 2; ++ai) {
            u32x2 res[4][2][2];
#pragma unroll
            for (int m = 0; m < 4; ++m) { const bf16_t* rp = xb + (size_t)(row0 + ai * HALF + m * 16) * DM + col0;
#pragma unroll
                for (int bj = 0; bj < 2; ++bj)
#pragma unroll
                    for (int n = 0; n < 2; ++n) res[m][bj][n] = __builtin_nontemporal_load((const u32x2*)(rp + bj * HALF + n * 16)); }
#pragma unroll
            for (int m = 0; m < 4; ++m) { float* rp = Y + (size_t)(row0 + ai * HALF + m * 16) * DM + col0;
#pragma unroll
                for (int bj = 0; bj < 2; ++bj)
#pragma unroll
                    for (int n = 0; n < 2; ++n) { const u32x2 w = res[m][bj][n];
                        *(f32x4*)(rp + bj * HALF + n * 16) = (f32x4){bflo(w.x), bfhi(w.x), bflo(w.y), bfhi(w.y)} + acc[ai][bj][m][n]; } }
            asm volatile("" ::: "memory"); }
    }
};
__device__ __forceinline__ float dpp_prev1(float cur, float prev) {
    const int t = __builtin_amdgcn_update_dpp(0, __builtin_bit_cast(int, cur), 0x111, 0xf, 0xf, true);
    return __builtin_bit_cast(float, __builtin_amdgcn_update_dpp(t, __builtin_bit_cast(int, prev), 0x10F, 0xf, 0xf, false));
}
__device__ __forceinline__ float dpp_prev2(float cur, float prev) {
    const int t = __builtin_amdgcn_update_dpp(0, __builtin_bit_cast(int, cur), 0x112, 0xf, 0xf, true);
    return __builtin_bit_cast(float, __builtin_amdgcn_update_dpp(t, __builtin_bit_cast(int, prev), 0x10E, 0xf, 0xf, false));
}
struct EpiUp {
    static constexpr bool PERM = true;
    bf16_t* act; float* HT; float* UPS; const float* ssq2; const float* cw; const float* cb; LAS float* halo;
    __device__ __forceinline__ void operator()(Acc& acc, const Unit& u, int wr, int wc, int fr, int fq) const {
        const int row0 = u.pm * BM + wr * 64 + fr; const int cl = wc * 32 + 8 * fq;
#pragma unroll
        for (int ai = 0; ai < 2; ++ai) {
            f32x4 sq[4][4];
#pragma unroll
            for (int m = 0; m < 4; ++m) { const f32x4* sp = (const f32x4*)(ssq2 + (size_t)(row0 + ai * HALF + m * 16) * 16);
#pragma unroll
                for (int q = 0; q < 4; ++q) sq[m][q] = sp[q]; }
#pragma unroll
            for (int m = 0; m < 4; ++m) {
                const f32x4 t = (sq[m][0] + sq[m][1]) + (sq[m][2] + sq[m][3]);
                const float rs = __builtin_amdgcn_rsqf(((t[0] + t[1]) + (t[2] + t[3])) * (1.0f / DM) + EPS);
#pragma unroll
                for (int bj = 0; bj < 2; ++bj)
#pragma unroll
                    for (int n = 0; n < 2; ++n) acc[ai][bj][m][n] = acc[ai][bj][m][n] * rs; }
            asm volatile("" ::: "memory"); }
        if (u.pm >= MP / BM) {
#pragma unroll
            for (int ai = 0; ai < 2; ++ai)
#pragma unroll
                for (int m = 0; m < 4; ++m) { const int srow = row0 + ai * HALF + m * 16 - MP;
#pragma unroll
                    for (int bj = 0; bj < 2; ++bj)
#pragma unroll
                        for (int n = 0; n < 2; ++n) *(f32x4*)(UPS + (size_t)srow * FF2 + bj * FF + u.pn * HALF + cl + 4 * n) = acc[ai][bj][m][n]; }
            return; }
        if (fr >= 14) {
#pragma unroll
            for (int ai = 0; ai < 2; ++ai) { const int s = ai * 2 + wr;
#pragma unroll
                for (int bj = 0; bj < 2; ++bj)
#pragma unroll
                    for (int n = 0; n < 2; ++n) *(LAS f32x4*)(halo + ((s * 2 + (fr - 14)) * 2 + bj) * HALF + cl + 4 * n) = acc[ai][bj][3][n]; }
            if (wr == 1) {
#pragma unroll
                for (int bj = 0; bj < 2; ++bj)
#pragma unroll
                    for (int n = 0; n < 2; ++n) *(f32x4*)(HT + ((size_t)u.pm * 4 + 2 + (fr - 14)) * FF2 + bj * FF + u.pn * HALF + cl + 4 * n) = acc[1][bj][3][n]; }
        }
        if (fr < 2 && wr == 0) {
#pragma unroll
            for (int bj = 0; bj < 2; ++bj)
#pragma unroll
                for (int n = 0; n < 2; ++n) *(f32x4*)(HT + ((size_t)u.pm * 4 + fr) * FF2 + bj * FF + u.pn * HALF + cl + 4 * n) = acc[0][bj][0][n];
        }
        asm volatile("s_waitcnt lgkmcnt(0)" ::: "memory"); __builtin_amdgcn_s_barrier(); asm volatile("" ::: "memory");
#pragma unroll
        for (int n = 0; n < 2; ++n) {
            const int col = u.pn * HALF + cl + 4 * n;
            const f32x4 w0a = *(const f32x4*)(cw + col), w1a = *(const f32x4*)(cw + FF2 + col), w2a = *(const f32x4*)(cw + 2 * FF2 + col), bba = *(const f32x4*)(cb + col);
            const f32x4 w0b = *(const f32x4*)(cw + FF + col), w1b = *(const f32x4*)(cw + FF2 + FF + col), w2b = *(const f32x4*)(cw + 2 * FF2 + FF + col), bbb = *(const f32x4*)(cb + FF + col);
#pragma unroll
            for (int ai = 0; ai < 2; ++ai) {
                const int s = ai * 2 + wr;
                f32x4 ha = (f32x4){0.f, 0.f, 0.f, 0.f}, hb = ha;
                if (s > 0 && fr >= 14) { ha = *(const LAS f32x4*)(halo + (((s - 1) * 2 + (fr - 14)) * 2 + 0) * HALF + cl + 4 * n);
                                          hb = *(const LAS f32x4*)(halo + (((s - 1) * 2 + (fr - 14)) * 2 + 1) * HALF + cl + 4 * n); }
#pragma unroll
                for (int m = 0; m < 4; ++m) {
                    const f32x4 ca = acc[ai][0][m][n], cbv = acc[ai][1][m][n];
                    const f32x4 pa = (m > 0) ? acc[ai][0][m > 0 ? m - 1 : 0][n] : ha, pb = (m > 0) ? acc[ai][1][m > 0 ? m - 1 : 0][n] : hb;
                    float res[4];
#pragma unroll
                    for (int e = 0; e < 4; ++e) {
                        const float a1 = dpp_prev1(ca[e], pa[e]), a2 = dpp_prev2(ca[e], pa[e]);
                        const float b1 = dpp_prev1(cbv[e], pb[e]), b2 = dpp_prev2(cbv[e], pb[e]);
                        const float ua = bba[e] + w0a[e] * a2 + w1a[e] * a1 + w2a[e] * ca[e];
                        const float ub = bbb[e] + w0b[e] * b2 + w1b[e] * b1 + w2b[e] * cbv[e];
                        res[e] = gelu_tanh(ua) * ub; }
                    const int row = row0 + ai * HALF + m * 16;
                    u32x2 w; w.x = cvt_pk_bf16(res[0], res[1]); w.y = cvt_pk_bf16(res[2], res[3]);
                    *(u32x2*)(act + (size_t)row * FF + col) = w;
                    asm volatile("" ::: "memory"); } } }
    }
};
}

namespace att {
#define KSWZ(row, colB) ((row) * 256 + ((colB) ^ (((row) & 7) << 4)))
#define SBAR() __builtin_amdgcn_sched_barrier(0)
constexpr int SHM_V = 64 * 64 * 2, SHM_K = 64 * 256;
constexpr float THR = 8.f;
__device__ __forceinline__ int crow(int r, int hi) { return (r & 3) + 8 * (r >> 2) + 4 * hi; }
typedef __bf16 bf16x2_t __attribute__((ext_vector_type(2)));
__device__ __forceinline__ unsigned cvtpk(float lo, float hi) { const f32x2 v = {lo, hi}; return __builtin_bit_cast(unsigned, __builtin_convertvector(v, bf16x2_t)); }
__device__ __forceinline__ void partialSM(f32x16& p0, f32x16& p1, float& m_reg, float& alpha) {
    float pmax = p0[0];
#pragma unroll
    for (int r = 1; r < 16; ++r) pmax = fmaxf(pmax, p0[r]);
#pragma unroll
    for (int r = 0; r < 16; ++r) pmax = fmaxf(pmax, p1[r]);
    { auto rr = __builtin_amdgcn_permlane32_swap(__float_as_uint(pmax), __float_as_uint(pmax), false, false);
      pmax = fmaxf(__uint_as_float(rr[0]), __uint_as_float(rr[1])); }
    float mn;
    if (__builtin_expect(__all(pmax - m_reg <= THR), 1)) { mn = m_reg; alpha = 1.f; }
    else { mn = fmaxf(m_reg, pmax); alpha = __builtin_amdgcn_exp2f(m_reg - mn); m_reg = mn; }
#pragma unroll
    for (int r = 0; r < 16; ++r) p0[r] = p0[r] - mn;
#pragma unroll
    for (int r = 0; r < 16; ++r) p1[r] = p1[r] - mn;
#pragma unroll
    for (int r = 0; r < 16; ++r) p0[r] = __builtin_amdgcn_exp2f(p0[r]);
}
__device__ __forceinline__ void finishSM(f32x16& p0, f32x16& p1, float alpha, float& l_reg, bf16x8& pa0, bf16x8& pa1, bf16x8& pa2, bf16x8& pa3) {
#pragma unroll
    for (int r = 0; r < 16; ++r) p1[r] = __builtin_amdgcn_exp2f(p1[r]);
    float ps = 0;
#pragma unroll
    for (int r = 0; r < 16; ++r) ps += p0[r];
#pragma unroll
    for (int r = 0; r < 16; ++r) ps += p1[r];
    { auto rr = __builtin_amdgcn_permlane32_swap(__float_as_uint(ps), __float_as_uint(ps), false, false);
      ps = __uint_as_float(rr[0]) + __uint_as_float(rr[1]); }
    l_reg = l_reg * alpha + ps;
#define PK4(P, BASE, OUT) do { unsigned a0 = cvtpk(P[BASE + 0], P[BASE + 1]), a1 = cvtpk(P[BASE + 2], P[BASE + 3]);   \
    unsigned b0 = cvtpk(P[BASE + 4], P[BASE + 5]), b1 = cvtpk(P[BASE + 6], P[BASE + 7]);                              \
    auto r0 = __builtin_amdgcn_permlane32_swap(a0, b0, false, false); auto r1 = __builtin_amdgcn_permlane32_swap(a1, b1, false, false); \
    u32x4 w = {r0[0], r1[0], r0[1], r1[1]}; OUT = __builtin_bit_cast(bf16x8, w); } while (0)
    PK4(p0, 0, pa0); PK4(p0, 8, pa1); PK4(p1, 0, pa2); PK4(p1, 8, pa3);
#undef PK4
}
__device__ __forceinline__ void qkt(f32x16& p0, f32x16& p1, const char* Ks, const bf16x8* qr, int r32, int hi, int tile, int kv_limit) {
    p0 = f32x16{}; p1 = f32x16{};
#pragma unroll
    for (int d0 = 0; d0 < 6; ++d0) { const int cb = (d0 * 16 + hi * 8) * 2;
        const bf16x8 b0 = *reinterpret_cast<const bf16x8*>(Ks + KSWZ(r32, cb));
        const bf16x8 b1 = *reinterpret_cast<const bf16x8*>(Ks + KSWZ(32 + r32, cb));
        p0 = __builtin_amdgcn_mfma_f32_32x32x16_bf16(b0, qr[d0], p0, 0, 0, 0);
        p1 = __builtin_amdgcn_mfma_f32_32x32x16_bf16(b1, qr[d0], p1, 0, 0, 0); }
}
__device__ __forceinline__ void qkt_n(f32x16& p0, f32x16& p1, const char* Ks, const bf16x8* qr, int r32, int hi, const f32x16& negm) {
#pragma unroll
    for (int d0 = 0; d0 < 6; ++d0) { const int cb = (d0 * 16 + hi * 8) * 2;
        const bf16x8 b0 = *reinterpret_cast<const bf16x8*>(Ks + KSWZ(r32, cb));
        const bf16x8 b1 = *reinterpret_cast<const bf16x8*>(Ks + KSWZ(32 + r32, cb));
        if (d0 == 0) { p0 = __builtin_amdgcn_mfma_f32_32x32x16_bf16(b0, qr[0], negm, 0, 0, 0); p1 = __builtin_amdgcn_mfma_f32_32x32x16_bf16(b1, qr[0], negm, 0, 0, 0); }
        else { p0 = __builtin_amdgcn_mfma_f32_32x32x16_bf16(b0, qr[d0], p0, 0, 0, 0); p1 = __builtin_amdgcn_mfma_f32_32x32x16_bf16(b1, qr[d0], p1, 0, 0, 0); } }
}
__device__ __forceinline__ void partialSMn(f32x16& p0, f32x16& p1, float& m_reg, float& alpha, f32x16& negm) {
    float pmax = p0[0];
#pragma unroll
    for (int r = 1; r < 16; ++r) pmax = fmaxf(pmax, p0[r]);
#pragma unroll
    for (int r = 0; r < 16; ++r) pmax = fmaxf(pmax, p1[r]);
    { auto rr = __builtin_amdgcn_permlane32_swap(__float_as_uint(pmax), __float_as_uint(pmax), false, false);
      pmax = fmaxf(__uint_as_float(rr[0]), __uint_as_float(rr[1])); }
    if (__builtin_expect(__all(pmax <= THR), 1)) { alpha = 1.f; }
    else { const float dl = fmaxf(pmax, 0.f); alpha = __builtin_amdgcn_exp2f(-dl); m_reg += dl;
#pragma unroll
        for (int r = 0; r < 16; ++r) { p0[r] -= dl; p1[r] -= dl; }
#pragma unroll
        for (int r = 0; r < 16; ++r) negm[r] = -m_reg; }
#pragma unroll
    for (int r = 0; r < 16; ++r) p0[r] = __builtin_amdgcn_exp2f(p0[r]);
}
__device__ __forceinline__ void kmask(f32x16& p0, f32x16& p1, int hi, int tile, int kv_limit) {
    if (64 * (tile + 1) > kv_limit) {
        const int base = 64 * tile + 4 * hi;
#pragma unroll
        for (int r = 0; r < 16; ++r) { const int kv = base + (r & 3) + 8 * (r >> 2); if (kv >= kv_limit) p0[r] = -1e30f; if (kv + 32 >= kv_limit) p1[r] = -1e30f; }
    }
}
__device__ __forceinline__ int v_st(int k, int c) { const int kk = (k & ~0xC) | ((k & 4) << 1) | ((k & 8) >> 1); return ((kk >> 3) * 2 + (c >> 5)) * 512 + ((kk & 7) * 32 + (c & 31)) * 2; }
__device__ __forceinline__ int v_rd_base(int lane) { return ((lane & 3) << 3) | (((lane >> 2) & 3) << 6) | (((lane >> 4) & 1) << 5) | (((lane >> 5) & 1) << 8); }
constexpr int v_rd_off(int d0, int ks, int half) { return d0 * 512 + ks * 2048 + half * 1024; }
template <int OFF> __device__ __forceinline__ s16x4 tr_read(int vb) {
    s16x4 r; asm volatile("ds_read_b64_tr_b16 %0, %1 offset:%2" : "=&v"(r) : "v"(vb), "i"(OFF) : "memory"); return r;
}
template <int D0> __device__ __forceinline__ void pv_one(f32x16& od, int vb, bf16x8 pa0, bf16x8 pa1, bf16x8 pa2, bf16x8 pa3) {
    const s16x4 l0 = tr_read<v_rd_off(D0, 0, 0)>(vb), h0 = tr_read<v_rd_off(D0, 0, 1)>(vb), l1 = tr_read<v_rd_off(D0, 1, 0)>(vb), h1 = tr_read<v_rd_off(D0, 1, 1)>(vb);
    const s16x4 l2 = tr_read<v_rd_off(D0, 2, 0)>(vb), h2 = tr_read<v_rd_off(D0, 2, 1)>(vb), l3 = tr_read<v_rd_off(D0, 3, 0)>(vb), h3 = tr_read<v_rd_off(D0, 3, 1)>(vb);
    asm volatile("s_waitcnt lgkmcnt(0)" ::: "memory"); SBAR();
#define PK(L, H) (bf16x8){L[0], L[1], L[2], L[3], H[0], H[1], H[2], H[3]}
    od = __builtin_amdgcn_mfma_f32_32x32x16_bf16(pa0, PK(l0, h0), od, 0, 0, 0);
    od = __builtin_amdgcn_mfma_f32_32x32x16_bf16(pa1, PK(l1, h1), od, 0, 0, 0);
    od = __builtin_amdgcn_mfma_f32_32x32x16_bf16(pa2, PK(l2, h2), od, 0, 0, 0);
    od = __builtin_amdgcn_mfma_f32_32x32x16_bf16(pa3, PK(l3, h3), od, 0, 0, 0);
#undef PK
}
typedef short v4i16_t __attribute__((ext_vector_type(4)));
__device__ __forceinline__ s16x4 vtr(const LAS char* p) { return __builtin_bit_cast(s16x4, __builtin_amdgcn_ds_read_tr16_b64_v4i16((LAS v4i16_t*)p)); }
template <int D0> __device__ __forceinline__ void pv_one_b(f32x16& od, const LAS char* vp, bf16x8 pa0, bf16x8 pa1, bf16x8 pa2, bf16x8 pa3) {
    const s16x4 l0 = vtr(vp + v_rd_off(D0, 0, 0)), h0 = vtr(vp + v_rd_off(D0, 0, 1)), l1 = vtr(vp + v_rd_off(D0, 1, 0)), h1 = vtr(vp + v_rd_off(D0, 1, 1));
    const s16x4 l2 = vtr(vp + v_rd_off(D0, 2, 0)), h2 = vtr(vp + v_rd_off(D0, 2, 1)), l3 = vtr(vp + v_rd_off(D0, 3, 0)), h3 = vtr(vp + v_rd_off(D0, 3, 1));
#define PK(L, H) (bf16x8){L[0], L[1], L[2], L[3], H[0], H[1], H[2], H[3]}
    od = __builtin_amdgcn_mfma_f32_32x32x16_bf16(pa0, PK(l0, h0), od, 0, 0, 0);
    od = __builtin_amdgcn_mfma_f32_32x32x16_bf16(pa1, PK(l1, h1), od, 0, 0, 0);
    od = __builtin_amdgcn_mfma_f32_32x32x16_bf16(pa2, PK(l2, h2), od, 0, 0, 0);
    od = __builtin_amdgcn_mfma_f32_32x32x16_bf16(pa3, PK(l3, h3), od, 0, 0, 0);
#undef PK
}
__device__ __forceinline__ void pv_d0b(f32x16* o, const LAS char* vp, bf16x8 pa0, bf16x8 pa1, bf16x8 pa2, bf16x8 pa3) {
    pv_one_b<0>(o[0], vp, pa0, pa1, pa2, pa3); pv_one_b<1>(o[1], vp, pa0, pa1, pa2, pa3);
}
__device__ __forceinline__ void pv_d0(f32x16* o, int vb, bf16x8 pa0, bf16x8 pa1, bf16x8 pa2, bf16x8 pa3) {
    pv_one<0>(o[0], vb, pa0, pa1, pa2, pa3); pv_one<1>(o[1], vb, pa0, pa1, pa2, pa3);
}
template <bool ALLACT> __device__ __forceinline__ void attn_unit(const bf16_t* __restrict__ Qb, const bf16_t* __restrict__ Kn, const bf16_t* __restrict__ Kr, const bf16_t* __restrict__ Vh,
                                          bf16_t* __restrict__ Ob, int NT, int kv_limit, bool active_, int nq_valid, char* lds) {
    const bool active = ALLACT ? true : active_;
    int tid = threadIdx.x; asm volatile("" : "+v"(tid));
    const int wid = tid >> 6, lane = tid & 63, r32 = lane & 31, hi = lane >> 5;
    char* V_lds = lds; char* K_lds = lds + 3 * SHM_V;
    float* ws = (float*)(lds + 3 * SHM_V + 3 * SHM_K) + wid * 64; float* li_l = ws; float* al_l = ws + 32;
    float m_reg = -1e30f, l_reg = 0; f32x16 o[2] = {}; bf16x8 qr[6];
    const bf16_t* Qw = Qb + (size_t)(wid * 32 + r32) * NQ + hi * 8;
#pragma unroll
    for (int d0 = 0; d0 < 6; ++d0) qr[d0] = *reinterpret_cast<const bf16x8*>(Qw + d0 * 16);
    const int kr0 = tid / 12, kc0 = tid % 12, kr1 = (512 + (tid >> 1)) / 12, kc1 = (512 + (tid >> 1)) % 12, kh1 = tid & 1, vr = tid >> 3, vc = tid & 7;
    const bf16_t* kp0 = (kc0 < 8) ? Kn + (size_t)kr0 * 1024 + kc0 * 8 : Kr + (size_t)kr0 * 32 + (kc0 - 8) * 8; const size_t ks0 = (kc0 < 8) ? 64 * 1024 : 64 * 32;
    const bf16_t* kp1 = ((kc1 < 8) ? Kn + (size_t)kr1 * 1024 + kc1 * 8 : Kr + (size_t)kr1 * 32 + (kc1 - 8) * 8) + kh1 * 4; const size_t ks1 = (kc1 < 8) ? 64 * 1024 : 64 * 32;
    const bf16_t* vp = Vh + (size_t)vr * 1024 + vc * 8;
    const int kst0 = KSWZ(kr0, kc0 * 16), kst1 = KSWZ(kr1, kc1 * 16) + kh1 * 8, vst = v_st(vr, vc * 8);
    const LAS char* vp0 = (const LAS char*)(LAS char*)V_lds + v_rd_base(lane);
    struct { bf16x8 k0; s16x4 k1; bf16x8 v; } sr_[2];
#define SLOAD(i, t) do { sr_[i].k0 = *reinterpret_cast<const bf16x8*>(kp0 + (size_t)(t) * ks0); sr_[i].k1 = *reinterpret_cast<const s16x4*>(kp1 + (size_t)(t) * ks1); \
    sr_[i].v = *reinterpret_cast<const bf16x8*>(vp + (size_t)(t) * 65536); } while (0)
#define SWRITE(b, i) do { *(bf16x8*)(K_lds + (b) * SHM_K + kst0) = sr_[i].k0; *(s16x4*)(K_lds + (b) * SHM_K + kst1) = sr_[i].k1; \
    *(bf16x8*)(V_lds + (b) * SHM_V + vst) = sr_[i].v; } while (0)
#define RESC(a) do { if (active) { if (__any((a) < 1.f)) { if (hi == 0) al_l[r32] = (a); asm volatile("s_waitcnt lgkmcnt(0)" ::: "memory"); \
    _Pragma("unroll") for (int d = 0; d < 2; ++d) _Pragma("unroll") for (int r = 0; r < 16; ++r) o[d][r] *= al_l[crow(r, hi)]; } } } while (0)
    f32x16 pA0 = {}, pA1 = {}, pB0 = {}, pB1 = {}; float alA = 1.f, alB = 1.f; bf16x8 pa0, pa1, pa2, pa3;
    SLOAD(0, 0); SWRITE(0, 0); SLOAD(1, 1); if (2 < NT) SLOAD(0, 2);
    __syncthreads();
    if (active) { qkt(pA0, pA1, K_lds, qr, r32, hi, 0, kv_limit); kmask(pA0, pA1, hi, 0, kv_limit); partialSM(pA0, pA1, m_reg, alA); }
    f32x16 negm;
#pragma unroll
    for (int r = 0; r < 16; ++r) negm[r] = -m_reg;
    SWRITE(1, 1); if (3 < NT) SLOAD(1, 3);
    __syncthreads();
    int sp = 0, sc = 1, sn = 2;
    for (int j = 1; j + 1 < NT; j += 2) {
        if (active) { SBAR(); qkt_n(pB0, pB1, K_lds + sc * SHM_K, qr, r32, hi, negm);
            finishSM(pA0, pA1, alA, l_reg, pa0, pa1, pa2, pa3); SBAR(); }
        SWRITE(sn, 0); if (j + 3 < NT) SLOAD(0, j + 3);
        SBAR();
        if (active) { kmask(pB0, pB1, hi, j, kv_limit); SBAR(); pv_d0b(o, vp0 + sp * SHM_V, pa0, pa1, pa2, pa3); partialSMn(pB0, pB1, m_reg, alB, negm); }
        RESC(alB); __syncthreads();
        { const int t_ = sp; sp = sc; sc = sn; sn = t_; }
        if (active) { SBAR(); qkt_n(pA0, pA1, K_lds + sc * SHM_K, qr, r32, hi, negm);
            finishSM(pB0, pB1, alB, l_reg, pa0, pa1, pa2, pa3); SBAR(); }
        if (j + 2 < NT) { SWRITE(sn, 1); if (j + 4 < NT) SLOAD(1, j + 4); }
        SBAR();
        if (active) { kmask(pA0, pA1, hi, j + 1, kv_limit); SBAR(); pv_d0b(o, vp0 + sp * SHM_V, pa0, pa1, pa2, pa3); partialSMn(pA0, pA1, m_reg, alA, negm); }
        RESC(alA); __syncthreads();
        { const int t_ = sp; sp = sc; sc = sn; sn = t_; }
    }
    if (active) {
        SBAR(); qkt_n(pB0, pB1, K_lds + sc * SHM_K, qr, r32, hi, negm);
        finishSM(pA0, pA1, alA, l_reg, pa0, pa1, pa2, pa3); SBAR();
        kmask(pB0, pB1, hi, NT - 1, kv_limit); SBAR();
        pv_d0b(o, vp0 + sp * SHM_V, pa0, pa1, pa2, pa3); partialSMn(pB0, pB1, m_reg, alB, negm);
    }
    RESC(alB);
    if (active) {
        finishSM(pB0, pB1, alB, l_reg, pa0, pa1, pa2, pa3); SBAR();
        pv_d0b(o, vp0 + sc * SHM_V, pa0, pa1, pa2, pa3);
        if (hi == 0) li_l[r32] = l_reg; asm volatile("s_waitcnt lgkmcnt(0)" ::: "memory");
        float rli[16];
#pragma unroll
        for (int r = 0; r < 16; ++r) rli[r] = __builtin_amdgcn_rcpf(li_l[crow(r, hi)]);
        bf16_t* Ow = Ob + (size_t)(wid * 32) * 1024;
#pragma unroll
        for (int r = 0; r < 16; ++r) { const int orow = crow(r, hi);
            if (wid * 32 + orow < nq_valid) {
#pragma unroll
                for (int d0 = 0; d0 < 2; ++d0) Ow[(size_t)orow * 1024 + d0 * 32 + r32] = (bf16_t)f2bf(o[d0][r] * rli[r]); } }
    }
    __syncthreads();
#undef SLOAD
#undef SWRITE
#undef RESC
}

__device__ __forceinline__ int v_st8(int k, int c) { const int kk = (k & ~0xC) | ((k & 4) << 1) | ((k & 8) >> 1); return ((kk >> 3) * 8 + (c >> 5)) * 512 + ((kk & 7) * 32 + (c & 31)) * 2; }
#define KSWZ5(row, colB) ((row) * 512 + ((colB) ^ (((row) & 7) << 4)))
constexpr int SL_QL = 0, SL_KL = 0, SL_KR = 32768, SL_V = 36864, SL_WS = 73728;
template <int D0> __device__ __forceinline__ void pv8_one(f32x16& od, int vb, bf16x8 pa0, bf16x8 pa1, bf16x8 pa2, bf16x8 pa3) {
    const s16x4 l0 = tr_read<D0 * 512 + 0 * 8192>(vb), h0 = tr_read<D0 * 512 + 0 * 8192 + 4096>(vb), l1 = tr_read<D0 * 512 + 1 * 8192>(vb), h1 = tr_read<D0 * 512 + 1 * 8192 + 4096>(vb);
    const s16x4 l2 = tr_read<D0 * 512 + 2 * 8192>(vb), h2 = tr_read<D0 * 512 + 2 * 8192 + 4096>(vb), l3 = tr_read<D0 * 512 + 3 * 8192>(vb), h3 = tr_read<D0 * 512 + 3 * 8192 + 4096>(vb);
    asm volatile("s_waitcnt lgkmcnt(0)" ::: "memory"); SBAR();
#define PK(L, H) (bf16x8){L[0], L[1], L[2], L[3], H[0], H[1], H[2], H[3]}
    od = __builtin_amdgcn_mfma_f32_32x32x16_bf16(pa0, PK(l0, h0), od, 0, 0, 0);
    od = __builtin_amdgcn_mfma_f32_32x32x16_bf16(pa1, PK(l1, h1), od, 0, 0, 0);
    od = __builtin_amdgcn_mfma_f32_32x32x16_bf16(pa2, PK(l2, h2), od, 0, 0, 0);
    od = __builtin_amdgcn_mfma_f32_32x32x16_bf16(pa3, PK(l3, h3), od, 0, 0, 0);
#undef PK
}
__device__ __forceinline__ bf16x8 cvt8(f32x4 a, f32x4 b) { u32x4 w = {cvtpk(a[0], a[1]), cvtpk(a[2], a[3]), cvtpk(b[0], b[1]), cvtpk(b[2], b[3])}; return __builtin_bit_cast(bf16x8, w); }
__device__ __forceinline__ void sample_unit(int b, int s, const bf16_t* __restrict__ Q, const float* __restrict__ w_uk, const float* __restrict__ cckv, const float* __restrict__ ckr,
                                            const bf16_t* __restrict__ ckvn, const bf16_t* __restrict__ kr, float* __restrict__ PO, float* __restrict__ PM, float* __restrict__ PL, char* lds) {
    int tid = threadIdx.x; asm volatile("" : "+v"(tid));
    const int wid = __builtin_amdgcn_readfirstlane(tid >> 6), lane = tid & 63, r32 = lane & 31, hi = lane >> 5;
    const int rbq = wid & 3, vh = wid >> 2;
    {
        const int h = wid;
        const bf16_t* qrow = Q + ((size_t)MP + (size_t)b * DS + (r32 & 15)) * NQ + h * 96;
        bf16x8 aq[4];
#pragma unroll
        for (int ks = 0; ks < 4; ++ks) { aq[ks] = *reinterpret_cast<const bf16x8*>(qrow + ks * 16 + hi * 8); if (r32 >= 16) aq[ks] = bf16x8{}; }
#pragma unroll 2
        for (int rb = 0; rb < 8; ++rb) {
            f32x16 acc = {};
            const float* wp = w_uk + ((size_t)(rb * 32 + r32) * 8 + h) * 64 + hi * 8;
#pragma unroll
            for (int ks = 0; ks < 4; ++ks) { const f32x4 w0 = *(const f32x4*)(wp + ks * 16), w1 = *(const f32x4*)(wp + ks * 16 + 4);
                acc = __builtin_amdgcn_mfma_f32_32x32x16_bf16(aq[ks], cvt8(w0, w1), acc, 0, 0, 0); }
#pragma unroll
            for (int i = 0; i < 8; ++i) { const int t = (i & 3) + 8 * (i >> 2) + 4 * hi;
                *(bf16_t*)(lds + SL_QL + (size_t)(h * 16 + t) * 576 + (rb * 32 + r32) * 2) = (bf16_t)f2bf(acc[i]); }
        }
        { const int t = lane >> 2, j8 = (lane & 3) * 8;
          const bf16x8 rp = *reinterpret_cast<const bf16x8*>(Q + ((size_t)MP + (size_t)b * DS + t) * NQ + h * 96 + 64 + j8);
          *(bf16x8*)(lds + SL_QL + (size_t)(h * 16 + t) * 576 + (256 + j8) * 2) = rp; }
    }
    __syncthreads();
    bf16x8 qr[18];
#pragma unroll
    for (int d0 = 0; d0 < 18; ++d0) qr[d0] = *reinterpret_cast<const bf16x8*>(lds + SL_QL + (size_t)(rbq * 32 + r32) * 576 + (d0 * 16 + hi * 8) * 2);
    __syncthreads();
    char* Kl = lds + SL_KL; char* Kr = lds + SL_KR; char* Vl = lds + SL_V;
    float* wsl = (float*)(lds + SL_WS) + wid * 64; float* al_l = wsl;
    const int vb = (int)(uintptr_t)Vl + v_rd_base(lane) + vh * 4 * 512;
    float m_reg = -1e30f, l_reg = 0.f; f32x16 o[4] = {};
    const int ntile = (s == 7) ? 5 : 4;
    for (int j = 0; j < ntile; ++j) {
        const int kb = (j < 4) ? s * 256 + j * 64 : PAST;
        bf16x8 kc[4], rc = bf16x8{};
        if (kb < PAST) {
#pragma unroll
            for (int q = 0; q < 4; ++q) { const int c = tid + 512 * q, key = c >> 5, ch = c & 31;
                const float* src = cckv + ((size_t)b * PAST + kb + key) * KVL + ch * 8;
                kc[q] = cvt8(__builtin_nontemporal_load((const f32x4*)src), __builtin_nontemporal_load((const f32x4*)(src + 4))); }
            if (tid < 256) { const int key = tid >> 2, ch = tid & 3; const float* src = ckr + ((size_t)b * PAST + kb + key) * ROPE + ch * 8;
                rc = cvt8(__builtin_nontemporal_load((const f32x4*)src), __builtin_nontemporal_load((const f32x4*)(src + 4))); }
        } else {
#pragma unroll
            for (int q = 0; q < 4; ++q) { const int c = tid + 512 * q, key = c >> 5, ch = c & 31;
                kc[q] = (key < DS) ? *reinterpret_cast<const bf16x8*>(ckvn + ((size_t)MP + (size_t)b * DS + key) * KVL + ch * 8) : bf16x8{}; }
            if (tid < 256) { const int key = tid >> 2, ch = tid & 3;
                rc = (key < DS) ? *reinterpret_cast<const bf16x8*>(kr + ((size_t)MP + (size_t)b * DS + key) * ROPE + ch * 8) : bf16x8{}; }
        }
        __syncthreads();
#pragma unroll
        for (int q = 0; q < 4; ++q) { const int c = tid + 512 * q, key = c >> 5, ch = c & 31;
            *(bf16x8*)(Kl + KSWZ5(key, ch * 16)) = kc[q]; *(bf16x8*)(Vl + v_st8(key, ch * 8)) = kc[q]; }
        if (tid < 256) { const int key = tid >> 2, ch = tid & 3; *(bf16x8*)(Kr + key * 64 + ch * 16) = rc; }
        __syncthreads();
        f32x16 p0 = {}, p1 = {};
#pragma unroll
        for (int d0 = 0; d0 < 16; ++d0) { const int cb = (d0 * 16 + hi * 8) * 2;
            const bf16x8 b0 = *reinterpret_cast<const bf16x8*>(Kl + KSWZ5(r32, cb));
            const bf16x8 b1 = *reinterpret_cast<const bf16x8*>(Kl + KSWZ5(32 + r32, cb));
            p0 = __builtin_amdgcn_mfma_f32_32x32x16_bf16(b0, qr[d0], p0, 0, 0, 0);
            p1 = __builtin_amdgcn_mfma_f32_32x32x16_bf16(b1, qr[d0], p1, 0, 0, 0); }
#pragma unroll
        for (int d0 = 0; d0 < 2; ++d0) { const int cb = (d0 * 16 + hi * 8) * 2;
            const bf16x8 b0 = *reinterpret_cast<const bf16x8*>(Kr + r32 * 64 + cb);
            const bf16x8 b1 = *reinterpret_cast<const bf16x8*>(Kr + (32 + r32) * 64 + cb);
            p0 = __builtin_amdgcn_mfma_f32_32x32x16_bf16(b0, qr[16 + d0], p0, 0, 0, 0);
            p1 = __builtin_amdgcn_mfma_f32_32x32x16_bf16(b1, qr[16 + d0], p1, 0, 0, 0); }
        if (kb + 64 > PAST + DS) {
#pragma unroll
            for (int r = 0; r < 16; ++r) { const int kv = kb + 4 * hi + (r & 3) + 8 * (r >> 2); if (kv >= PAST + DS) p0[r] = -1e30f; if (kv + 32 >= PAST + DS) p1[r] = -1e30f; }
        }
        float alpha; bf16x8 pa0, pa1, pa2, pa3;
        partialSM(p0, p1, m_reg, alpha);
        finishSM(p0, p1, alpha, l_reg, pa0, pa1, pa2, pa3);
        if (__any(alpha < 1.f)) { if (hi == 0) al_l[r32] = alpha; asm volatile("s_waitcnt lgkmcnt(0)" ::: "memory");
#pragma unroll
            for (int d = 0; d < 4; ++d)
#pragma unroll
                for (int r = 0; r < 16; ++r) o[d][r] *= al_l[crow(r, hi)]; }
        SBAR();
        pv8_one<0>(o[0], vb, pa0, pa1, pa2, pa3); pv8_one<1>(o[1], vb, pa0, pa1, pa2, pa3); pv8_one<2>(o[2], vb, pa0, pa1, pa2, pa3); pv8_one<3>(o[3], vb, pa0, pa1, pa2, pa3);
    }
    const size_t pbase = ((size_t)b * 8 + s) * 128 + rbq * 32;
    if (vh == 0 && hi == 0) { PM[pbase + r32] = m_reg; PL[pbase + r32] = l_reg; }
#pragma unroll
    for (int r = 0; r < 16; ++r) { float* op = PO + (pbase + crow(r, hi)) * 256 + vh * 128 + r32;
#pragma unroll
        for (int d0 = 0; d0 < 4; ++d0) op[d0 * 32] = o[d0][r]; }
    __syncthreads();
}
#undef SBAR
}

struct Args { const float* in[28]; float* out; unsigned char* ws; };

__device__ __forceinline__ void transpose_item(const float* __restrict__ W, int ldw, const float* __restrict__ gk, bf16_t* WT, int K, int n_dst0, int n_src0, int k0, LAS float* scr, int lane) {
    float tv[32];
#pragma unroll
    for (int i = 0; i < 32; ++i) { const int kk = 2 * i + (lane >> 5); tv[i] = __builtin_nontemporal_load(&W[(size_t)(k0 + kk) * ldw + n_src0 + (lane & 31)]); }
#pragma unroll
    for (int i = 0; i < 32; ++i) { const int kk = 2 * i + (lane >> 5); float v = tv[i]; if (gk) v *= gk[k0 + kk]; scr[kk * 33 + (lane & 31)] = v; }
    asm volatile("s_waitcnt lgkmcnt(0)" ::: "memory");
    const int c = lane & 7;
#pragma unroll
    for (int j = 0; j < 4; ++j) { const int n = (lane >> 3) + 8 * j; const LAS float* s = scr + (8 * c) * 33 + n;
        u32x4 o; o.x = pk2(s[0 * 33], s[1 * 33]); o.y = pk2(s[2 * 33], s[3 * 33]); o.z = pk2(s[4 * 33], s[5 * 33]); o.w = pk2(s[6 * 33], s[7 * 33]);
        *(u32x4*)(WT + (size_t)(n_dst0 + n) * K + k0 + 8 * c) = o; }
    asm volatile("s_waitcnt lgkmcnt(0)" ::: "memory");
}


#define XB_TMO      128
#define XB_XCNT(j)  (256  + 64 * (j))
#define XB_XSUB(j)  (1280 + 64 * (j))
#define XB_XGEN(j)  (2304 + 64 * (j))
#define XB_TOP      3328
#define XB_TOPGEN   3392
#define XCD_BAR_WORDS 3456
#define XB_SPIN_CAP (1u << 22)
__device__ __forceinline__ unsigned xb_ld(unsigned* p)              { return __hip_atomic_load(p, __ATOMIC_RELAXED, __HIP_MEMORY_SCOPE_AGENT); }
__device__ __forceinline__ unsigned xb_add(unsigned* p, unsigned v) { return __hip_atomic_fetch_add(p, v, __ATOMIC_RELAXED, __HIP_MEMORY_SCOPE_AGENT); }
__device__ __forceinline__ unsigned xb_xcc_id() { return (unsigned)__builtin_amdgcn_s_getreg((3 << 11) | 20) & 0xFu; }
#define XB_SPIN(cond, bar) do { unsigned _sp = 0; while (cond) { __builtin_amdgcn_s_sleep(1); \
    if ((++_sp & 255u) == 0u) { if (xb_ld(&(bar)[XB_TMO])) break; if (_sp > XB_SPIN_CAP) { atomicAdd(&(bar)[XB_TMO], 1u); break; } } } } while (0)
struct XcdBarrier { unsigned* bar; unsigned x; volatile LAS unsigned* st; };
__device__ __forceinline__ XcdBarrier xcd_barrier_post(unsigned* bar, volatile LAS unsigned* st) {
    XcdBarrier b; b.bar = bar; b.x = xb_xcc_id(); b.st = st;
    if (threadIdx.x == 0) (void)xb_add(&bar[XB_XCNT(b.x)], 1u);
    return b;
}
__device__ __forceinline__ void xcd_barrier_complete(unsigned* bar, unsigned x, unsigned& nloc, unsigned& nx) {
    const unsigned G = gridDim.x * gridDim.y * gridDim.z;
    unsigned sum, cnt, mine, sp = 0u;
    for (;;) {
        sum = 0u; cnt = 0u; mine = 0u;
#pragma unroll
        for (unsigned j = 0; j < 16; ++j) { const unsigned c = xb_ld(&bar[XB_XCNT(j)]); sum += c; cnt += (c > 0u) ? 1u : 0u; mine = (j == x) ? c : mine; }
        if (sum == G) break;
        __builtin_amdgcn_s_sleep(1);
        if ((++sp & 255u) == 0u) { if (xb_ld(&bar[XB_TMO])) break; if (sp > XB_SPIN_CAP) { atomicAdd(&bar[XB_TMO], 1u); break; } }
    }
    nloc = mine > 0u ? mine : 1u; nx = cnt > 0u ? cnt : 1u;
}
__device__ __forceinline__ void xcd_barrier(const XcdBarrier& b) {
    asm volatile("s_waitcnt vmcnt(0)" ::: "memory");
    __syncthreads();
    if (threadIdx.x == 0) {
        unsigned* bar = b.bar;
        __builtin_amdgcn_s_waitcnt(0);
        unsigned nloc = b.st[0], nx = b.st[1];
        if (nloc == 0u) { xcd_barrier_complete(bar, b.x, nloc, nx); b.st[0] = nloc; b.st[1] = nx; }
        const unsigned old = xb_add(&bar[XB_XSUB(b.x)], 1u);
        const unsigned gen = old / nloc;
        if (old + 1u == (gen + 1u) * nloc) {
            __builtin_amdgcn_fence(__ATOMIC_RELEASE, "agent");
            asm volatile("s_waitcnt vmcnt(0)" ::: "memory");
            const unsigned og = xb_add(&bar[XB_TOP], 1u);
            const unsigned tg = og / nx;
            if (og + 1u == (tg + 1u) * nx) xb_add(&bar[XB_TOPGEN], 1u);
            else XB_SPIN(xb_ld(&bar[XB_TOPGEN]) == tg, bar);
            __builtin_amdgcn_fence(__ATOMIC_ACQUIRE, "agent");
            xb_add(&bar[XB_XGEN(b.x)], 1u);
            asm volatile("s_waitcnt vmcnt(0)" ::: "memory");
        } else {
            XB_SPIN(xb_ld(&bar[XB_XGEN(b.x)]) == gen, bar);
            __builtin_amdgcn_fence(__ATOMIC_ACQUIRE, "agent");
            asm volatile("s_waitcnt vmcnt(0)" ::: "memory");
        }
    }
    __syncthreads();
}
#define CAS __attribute__((address_space(4)))
__device__ __forceinline__ const float* karg_f(int k) { return ((const float* const CAS*)__builtin_amdgcn_kernarg_segment_ptr())[k]; }
__device__ __forceinline__ unsigned char* karg_ws() { return ((unsigned char* const CAS*)__builtin_amdgcn_kernarg_segment_ptr())[29]; }
__device__ __forceinline__ float* karg_out() { return ((float* const CAS*)__builtin_amdgcn_kernarg_segment_ptr())[28]; }
__global__ void __launch_bounds__(512, 2) fwd_megakernel(Args a) {
    extern __shared__ __attribute__((aligned(16))) unsigned char lds[];
    cg::grid_group grid = cg::this_grid();
    LAS unsigned char* ldsl = (LAS unsigned char*)lds;
    const int G = gridDim.x, bx = blockIdx.x;
    volatile LAS unsigned* MISC = (volatile LAS unsigned*)(ldsl + LDS_HALO + 8192);
    if (threadIdx.x < 8) MISC[threadIdx.x] = 0u;
    __syncthreads();
    XcdBarrier xbar = xcd_barrier_post((unsigned*)(karg_ws() + WS_BAR), MISC);
#define GRID_BAR() xcd_barrier(xbar)
#define PHASE_IDS() int tid = threadIdx.x; asm volatile("" : "+v"(tid)); const int lane = tid & 63, wave = __builtin_amdgcn_readfirstlane(tid >> 6); \
    const int vcu = (G % 8 == 0) ? (bx % 8) * (G / 8) + bx / 8 : bx; const int gw = vcu * 8 + wave, NGW = G * 8; \
    const unsigned gt = (unsigned)bx * 512u + (unsigned)tid, NGT = (unsigned)G * 512u; (void)lane; (void)gw; (void)NGW; (void)gt; (void)NGT; (void)vcu;
#define x_prompt (karg_f(0))
#define x_sample (karg_f(1))
#define cache_ckv (karg_f(2))
#define cache_krope (karg_f(3))
#define state_rg_h (karg_f(4))
#define state_rg_conv (karg_f(5))
#define state_ffn_conv (karg_f(6))
#define norm_mix_g (karg_f(7))
#define w_in (karg_f(8))
#define q_norm_g (karg_f(9))
#define w_uq (karg_f(10))
#define kv_norm_g (karg_f(11))
#define w_uk (karg_f(12))
#define w_uv (karg_f(13))
#define w_rg_conv (karg_f(14))
#define b_rg_conv (karg_f(15))
#define w_rg_a (karg_f(16))
#define b_rg_a (karg_f(17))
#define w_rg_i (karg_f(18))
#define b_rg_i (karg_f(19))
#define rg_lambda (karg_f(20))
#define w_out (karg_f(21))
#define norm_ffn_g (karg_f(22))
#define w_ffn_up (karg_f(23))
#define w_ffn_conv (karg_f(24))
#define b_ffn_conv (karg_f(25))
#define w_ffn_down (karg_f(26))
#define final_norm_g (karg_f(27))
#define ws (karg_ws())
#define out (karg_out())
#define SP ((float*)(ws + WS_SP))
#define SA ((float*)(ws + WS_SA))
#define SU ((float*)(ws + WS_SU))
#define ROPE_T ((f32x2*)(ws + WS_ROPE))
#define SSQ2 ((float*)(ws + WS_SSQ2))
#define SSQ3 ((float*)(ws + WS_SSQ3))
#define WIN ((bf16_t*)(ws + WS_WIN))
#define WUQ ((bf16_t*)(ws + WS_WUQ))
#define WKV ((bf16_t*)(ws + WS_WKV))
#define WRG ((bf16_t*)(ws + WS_WRG))
#define WOUT ((bf16_t*)(ws + WS_WOUT))
#define WUP ((bf16_t*)(ws + WS_WUP))
#define WDN ((bf16_t*)(ws + WS_WDN))
#define XN ((bf16_t*)(ws + WS_XN))
#define PROJ ((bf16_t*)(ws + WS_PROJ))
#define KV ((bf16_t*)(ws + WS_KV))
#define ACT ((bf16_t*)(ws + WS_ACT))
#define CQN ((bf16_t*)(ws + WS_CQN))
#define XC ((bf16_t*)(ws + WS_XC))
#define CKVN ((bf16_t*)(ws + WS_CKVN))
#define CAT ((bf16_t*)(ws + WS_CAT))
#define HT ((float*)(ws + WS_HT))
#define UPS ((float*)(ws + WS_UPS))
#define LA ((const _Float16*)(ws + WS_LA))
#define KR ((bf16_t*)(ws + WS_KR))
#define X1B ((bf16_t*)(ws + WS_X1B))
#define Y (out + O_Y)
#define QB ((bf16_t*)((unsigned char*)out + YS_Q))
#define GG ((bf16_t*)((unsigned char*)out + YS_GG))
#define UB ((bf16_t*)((unsigned char*)out + YS_U))
#if (PHMASK >> 0) & 1
    for (int rep_ = 0; rep_ <= ((DUPMASK >> 0) & 1); ++rep_)
    {
    PHASE_IDS();
    {
        LAS float* scr = (LAS float*)(ldsl + wave * 16384);
        constexpr int I_IN = 16 * 53, I_UQ = 6 * 24, I_KV = 4 * 32, I_OUT = 16 * 32, I_UP = 16 * 176, I_DN = 44 * 32;
        constexpr int NITEMS = I_IN + I_UQ + I_KV + I_OUT + I_UP + I_DN;
        for (int it = gw; it < NITEMS; it += NGW) {
            int r = it;
            if (r < I_IN) { const int kb = r / 53, nb = r % 53, n = nb * 32; const int src = (n < 640) ? n : (n < 1664 ? n + 32 : n - 1024);
                transpose_item(w_in, 1696, norm_mix_g, WIN, 1024, n, src, kb * 64, scr, lane); continue; } r -= I_IN;
            if (r < I_UQ) { const int kb = r / 24, nb = r % 24; transpose_item(w_uq, 768, q_norm_g, WUQ, 384, nb * 32, nb * 32, kb * 64, scr, lane); continue; } r -= I_UQ;
            if (r < I_KV) { const int kb = r / 32, nb = r % 32, n = nb * 32; transpose_item(n < 512 ? w_uk : w_uv, 512, nullptr, WKV, 256, n, n & 511, kb * 64, scr, lane); continue; } r -= I_KV;
            if (r < I_OUT) { const int kb = r / 32, nb = r % 32; transpose_item(w_out, 1024, nullptr, WOUT, 1024, nb * 32, nb * 32, kb * 64, scr, lane); continue; } r -= I_OUT;
            if (r < I_UP) { const int kb = r / 176, nb = r % 176, n = nb * 32; const int src = ((n >> 7) & 1) * FF + (n >> 8) * 128 + (n & 127);
                transpose_item(w_ffn_up, FF2, norm_ffn_g, WUP, 1024, n, src, kb * 64, scr, lane); continue; } r -= I_UP;
            { const int kb = r / 32, nb = r % 32; transpose_item(w_ffn_down, 1024, nullptr, WDN, FF, nb * 32, nb * 32, kb * 64, scr, lane); }
        }
        for (unsigned i = gt; i < (size_t)96 * 1024 / 8; i += NGT) ((u32x4*)(WIN + (size_t)1696 * 1024))[i] = (u32x4){0u, 0u, 0u, 0u};
        for (unsigned i = gt; i < (size_t)1024 * 64; i += NGT) {
            const int n = (int)(i >> 6), k0 = (int)(i & 63) * 8; const int ch = (n >> 8) * 128 + (n & 127), blk = ch >> 6, d = ch & 63;
            u32x4 o = (u32x4){0u, 0u, 0u, 0u};
            if ((k0 >> 6) == blk) { const float* w = (((n >> 7) & 1) ? w_rg_i : w_rg_a) + ((size_t)blk * 64 + (k0 & 63)) * 64 + d;
                o.x = pk2(w[0], w[64]); o.y = pk2(w[128], w[192]); o.z = pk2(w[256], w[320]); o.w = pk2(w[384], w[448]); }
            *(u32x4*)(WRG + (size_t)n * 512 + k0) = o; }
        for (unsigned i = gt; i < (size_t)8192 * 16; i += NGT) {
            const int pos = (int)(i >> 4), f = (int)(i & 15);
            const float inv = exp2f(-(float)f * 0.83048202372184059f);
            const float ang = (float)pos * inv;
            const float k = rintf(ang * 0.15915494309189535f);
            float rr = fmaf(-k, 6.28125f, ang); rr = fmaf(-k, 1.9353071795864769e-3f, rr);
            ROPE_T[i] = (f32x2){__cosf(rr), __sinf(rr)}; }
        if (bx == 0) SP[tid] = log1pf(expf(-rg_lambda[tid]));
        for (int r = gw; r < MT; r += NGW) {
            const f32x4* xr = (const f32x4*)(r < MP ? x_prompt + (size_t)r * DM : x_sample + (size_t)(r - MP) * DM) + lane;
            f32x4 v[4]; float s = 0.f;
#pragma unroll
            for (int j = 0; j < 4; ++j) { v[j] = __builtin_nontemporal_load(&xr[64 * j]); s += (v[j][0] * v[j][0] + v[j][1] * v[j][1]) + (v[j][2] * v[j][2] + v[j][3] * v[j][3]); }
            const float rs = 1.0f / sqrtf(wave_sum(s) * (1.0f / DM) + EPS);
            u32x2* o8 = (u32x2*)(XN + (size_t)r * DM) + lane;
#pragma unroll
            for (int j = 0; j < 4; ++j) { u32x2 w; w.x = pk2(v[j][0] * rs, v[j][1] * rs); w.y = pk2(v[j][2] * rs, v[j][3] * rs); o8[64 * j] = w; }
        }
    }
    }
#endif
    if (gridDim.x == 0x7fffffffu) grid.sync();
    GRID_BAR();

#if (PHMASK >> 1) & 1
    for (int rep_ = 0; rep_ <= ((DUPMASK >> 1) & 1); ++rep_)
    {
    PHASE_IDS();
    {
        pg8::Gemm g{XN, WIN, 1024, 1024}; pg8::StaticOrder S; S.init(MT, NIN, 1024, G, bx);
        pg8::EpiStore<false> E{PROJ, NIN};
        pg8::gemm_phase<pg8::EpiStore<false>, pg8::StaticOrder>(ldsl, g, S, E);
    }
    }
#endif
    GRID_BAR();

#if (PHMASK >> 2) & 1
    for (int rep_ = 0; rep_ <= ((DUPMASK >> 2) & 1); ++rep_)
    {
    PHASE_IDS();
    float kvg[2][2], brg[8], wrg[4][8];
#pragma unroll
    for (int j = 0; j < 2; ++j) { kvg[j][0] = kv_norm_g[2 * (lane + 64 * j)]; kvg[j][1] = kv_norm_g[2 * (lane + 64 * j) + 1]; }
#pragma unroll
    for (int e = 0; e < 8; ++e) { brg[e] = b_rg_conv[lane * 8 + e];
#pragma unroll
        for (int k = 0; k < 4; ++k) wrg[k][e] = w_rg_conv[k * RGW + lane * 8 + e]; }
    for (int r = gw; r < MT; r += NGW) {
        const bf16_t* pr = PROJ + (size_t)r * NIN;
        const bool isp = r < MP; const int rb = isp ? (r >> 13) : ((r - MP) >> 4), t = isp ? (r & (SEQ - 1)) : ((r - MP) & 15), TT = isp ? SEQ : DS;
        const int ch = lane * 8;
        unsigned wq[3], wkv[2];
#pragma unroll
        for (int j = 0; j < 3; ++j) wq[j] = __builtin_nontemporal_load(&((const unsigned*)pr)[lane + 64 * j]);
#pragma unroll
        for (int j = 0; j < 2; ++j) wkv[j] = __builtin_nontemporal_load(&((const unsigned*)(pr + C_CKV))[lane + 64 * j]);
        const bf16_t rx1 = pr[C_KR + (lane & 15)], rx2 = pr[C_KR + 16 + (lane & 15)]; const f32x2 cs = ROPE_T[(size_t)tok_pos(r) * 16 + (lane & 15)];
        u32x4 cwv[4];
#pragma unroll
        for (int k = 0; k < 4; ++k) { const int tt = t - 3 + k; cwv[k] = (tt >= 0) ? *(const u32x4*)(pr + (ptrdiff_t)(k - 3) * NIN + C_RGX + ch) : (u32x4){0u, 0u, 0u, 0u}; }
        const u32x4 gw4 = __builtin_nontemporal_load((const u32x4*)(pr + C_RGG + ch));
        { float s = 0.f;
#pragma unroll
          for (int j = 0; j < 3; ++j) { const float lo = bflo(wq[j]), hi = bfhi(wq[j]); s += lo * lo + hi * hi; }
          const float rs = 1.0f / sqrtf(wave_sum(s) * (1.0f / QL) + EPS);
#pragma unroll
          for (int j = 0; j < 3; ++j) ((unsigned*)(CQN + (size_t)r * QL))[lane + 64 * j] = pk2(bflo(wq[j]) * rs, bfhi(wq[j]) * rs); }
        { float s = 0.f;
#pragma unroll
          for (int j = 0; j < 2; ++j) { const float lo = bflo(wkv[j]), hi = bfhi(wkv[j]); s += lo * lo + hi * hi; }
          const float rs = 1.0f / sqrtf(wave_sum(s) * (1.0f / KVL) + EPS);
          float* co = isp ? out + O_PCKV + (size_t)r * KVL : out + O_SCKV + (size_t)(r - MP) * KVL;
#pragma unroll
          for (int j = 0; j < 2; ++j) { const int e = 2 * (lane + 64 * j); const float v0 = bflo(wkv[j]) * rs * kvg[j][0], v1 = bfhi(wkv[j]) * rs * kvg[j][1];
              __builtin_nontemporal_store((f32x2){v0, v1}, (f32x2*)(co + e)); ((unsigned*)(CKVN + (size_t)r * KVL))[lane + 64 * j] = pk2(v0, v1); } }
        if (lane < 16) { const float x1 = bf2f(rx1), x2 = bf2f(rx2);
            const float o1 = x1 * cs[0] - x2 * cs[1], o2 = x2 * cs[0] + x1 * cs[1];
            float* ko = isp ? out + O_PKR + (size_t)r * ROPE : out + O_SKR + (size_t)(r - MP) * ROPE;
            ko[lane] = o1; ko[lane + 16] = o2;
            bf16_t* kr = KR + (size_t)r * ROPE; kr[lane] = (bf16_t)f2bf(o1); kr[lane + 16] = (bf16_t)f2bf(o2); }
        { float xk[4][8];
#pragma unroll
          for (int k = 0; k < 4; ++k) { const int tt = t - 3 + k; const u32x4 w = cwv[k];
              xk[k][0] = bflo(w.x); xk[k][1] = bfhi(w.x); xk[k][2] = bflo(w.y); xk[k][3] = bfhi(w.y); xk[k][4] = bflo(w.z); xk[k][5] = bfhi(w.z); xk[k][6] = bflo(w.w); xk[k][7] = bfhi(w.w);
              if (tt < 0 && !isp) { const float* sb = state_rg_conv + ((size_t)rb * 3 + (t + k)) * RGW + ch;
#pragma unroll
                  for (int e = 0; e < 8; ++e) xk[k][e] = sb[e]; } }
          float xo[8];
#pragma unroll
          for (int e = 0; e < 8; ++e) { float v = brg[e];
#pragma unroll
              for (int k = 0; k < 4; ++k) v += wrg[k][e] * xk[k][e];
              xo[e] = v; }
          u32x4 w; w.x = pk2(xo[0], xo[1]); w.y = pk2(xo[2], xo[3]); w.z = pk2(xo[4], xo[5]); w.w = pk2(xo[6], xo[7]);
          *(u32x4*)(XC + (size_t)r * RGW + ch) = w;
          u32x4 go; go.x = pk2(gelu_tanh(bflo(gw4.x)), gelu_tanh(bfhi(gw4.x))); go.y = pk2(gelu_tanh(bflo(gw4.y)), gelu_tanh(bfhi(gw4.y)));
          go.z = pk2(gelu_tanh(bflo(gw4.z)), gelu_tanh(bfhi(gw4.z))); go.w = pk2(gelu_tanh(bflo(gw4.w)), gelu_tanh(bfhi(gw4.w)));
          *(u32x4*)(GG + (size_t)r * RGW + ch) = go;
          if (t >= TT - 3) { float* so = (isp ? out + O_PRGC : out + O_SRGC) + ((size_t)rb * 3 + (t - (TT - 3))) * RGW + ch;
#pragma unroll
              for (int e = 0; e < 8; ++e) so[e] = xk[3][e]; } }
    }
    }
#endif
    GRID_BAR();

#if (PHMASK >> 3) & 1
    for (int rep_ = 0; rep_ <= ((DUPMASK >> 3) & 1); ++rep_)
    {
    PHASE_IDS();
    {
#if P3SEL & 1
        { pg8::Gemm g{CQN, WUQ, QL, QL}; pg8::StaticOrder S; S.init(MT, NQ, QL, G, bx); pg8::EpiQ E{QB, ROPE_T}; pg8::gemm_phase<pg8::EpiQ, pg8::StaticOrder>(ldsl, g, S, E); }
#endif
#if P3SEL & 2
        { pg8::Gemm g{CKVN, WKV, KVL, KVL}; pg8::StaticOrder S; S.init(MP, 1024, KVL, G, bx); pg8::EpiStore<false> E{KV, 1024}; pg8::gemm_phase<pg8::EpiStore<false>, pg8::StaticOrder>(ldsl, g, S, E); }
#endif
#if P3SEL & 4
        { pg8::Gemm g{XC, WRG, RGW, RGW}; pg8::RgOrder S; S.S.init(MT, 1024, RGW, G, bx); pg8::EpiRG E{XC, b_rg_a, b_rg_i, SP, (_Float16*)(ws + WS_LA), UB}; pg8::gemm_phase<pg8::EpiRG, pg8::RgOrder>(ldsl, g, S, E); }
#endif
    }
    }
#endif
    GRID_BAR();

#if (PHMASK >> 4) & 1
    for (int rep_ = 0; rep_ <= ((DUPMASK >> 4) & 1); ++rep_)
    {
    PHASE_IDS();
    for (int it = gw; it < NB * 64 * 8; it += NGW) {
        const int g8 = it & 7, c = (it >> 3) & 63, b = it >> 9; const int ch = g8 * 64 + lane; const size_t r0 = (size_t)b * SEQ + c * 128;
        float S = 0.f, h = 0.f;
#pragma unroll 16
        for (int t = 0; t < 128; ++t) { const float l = (float)LA[(r0 + t) * RGW + ch] * (1.0f / 256.0f), uu = bf2f(UB[(r0 + t) * RGW + ch]); S += l; h = fexp(l) * h + uu; }
        SA[(size_t)(b * 64 + c) * RGW + ch] = S; SU[(size_t)(b * 64 + c) * RGW + ch] = h;
    }
    }
#endif
    GRID_BAR();

#if (PHMASK >> 5) & 1
    for (int rep_ = 0; rep_ <= ((DUPMASK >> 5) & 1); ++rep_)
    {
    PHASE_IDS();
    {
        for (int rp3 = 0; rp3 < RG_REP; ++rp3)
        for (int it = gw; it < NB * 64 * 8 + DB * 8; it += NGW) {
            if (it < NB * 64 * 8) {
                const int g8 = it & 7, c = (it >> 3) & 63, b = it >> 9; const int ch = g8 * 64 + lane; const size_t r0 = (size_t)b * SEQ + c * 128;
                float h = 0.f;
#pragma unroll 8
                for (int j = 0; j < c; ++j) h = fexp(SA[(size_t)(b * 64 + j) * RGW + ch]) * h + SU[(size_t)(b * 64 + j) * RGW + ch];
                for (int tb = 0; tb < 128; tb += 16) {
                    float lv[16]; bf16_t uv[16], gv[16];
#pragma unroll
                    for (int k = 0; k < 16; ++k) { const size_t r = r0 + tb + k; lv[k] = (float)__builtin_nontemporal_load(&LA[r * RGW + ch]) * (1.0f / 256.0f); uv[k] = __builtin_nontemporal_load(&UB[r * RGW + ch]); gv[k] = __builtin_nontemporal_load(&GG[r * RGW + ch]); }
#pragma unroll
                    for (int k = 0; k < 16; ++k) { const size_t r = r0 + tb + k; h = fexp(lv[k]) * h + bf2f(uv[k]);
                        CAT[r * DM + 512 + ch] = (bf16_t)f2bf(h * bf2f(gv[k])); }
                }
                if (c == 63) out[O_PRGH + (size_t)b * RGW + ch] = h;
            } else {
                const int i2 = it - NB * 64 * 8; const int g8 = i2 & 7, b = i2 >> 3; const int ch = g8 * 64 + lane; const size_t r0 = (size_t)MP + b * DS;
                float h = state_rg_h[(size_t)b * RGW + ch];
                float lv[16]; bf16_t uv[16], gv[16];
#pragma unroll
                for (int k = 0; k < 16; ++k) { const size_t r = r0 + k; lv[k] = (float)__builtin_nontemporal_load(&LA[r * RGW + ch]) * (1.0f / 256.0f); uv[k] = __builtin_nontemporal_load(&UB[r * RGW + ch]); gv[k] = __builtin_nontemporal_load(&GG[r * RGW + ch]); }
#pragma unroll
                for (int k = 0; k < 16; ++k) { const size_t r = r0 + k; h = fexp(lv[k]) * h + bf2f(uv[k]);
                    CAT[r * DM + 512 + ch] = (bf16_t)f2bf(h * bf2f(gv[k])); }
                out[O_SRGH + (size_t)b * RGW + ch] = h;
            }
        }
        __syncthreads();
        for (int idx = vcu; idx < 1280; idx += G) {
            if (idx < 1024) {
                const int i = idx >> 8, v = idx & 255, bh = v >> 3, s = v & 7, b = bh >> 3, h = bh & 7;
                const int qb = (i == 0) ? 31 - s : (i == 1) ? 16 + s : (i == 2) ? 15 - s : s;
                const size_t q0 = (size_t)b * SEQ + (size_t)qb * 256, k0 = (size_t)b * SEQ;
                att::attn_unit<true>(QB + q0 * NQ + h * 96, KV + k0 * 1024 + h * 64, KR + k0 * ROPE, KV + k0 * 1024 + 512 + h * 64, CAT + q0 * DM + h * 64,
                               4 * qb + 4, 64 * (4 * qb + (wave >> 1) + 1), true, 256, (char*)lds);
            } else {
                const int v = idx - 1024;
                for (int rp2 = 0; rp2 < SAMPLE_REP; ++rp2)
                att::sample_unit(v >> 3, v & 7, QB, w_uk, cache_ckv, cache_krope, CKVN, KR, (float*)(ws + WS_PO), (float*)(ws + WS_PM), (float*)(ws + WS_PL), (char*)lds);
            }
        }
    }
    }
#endif
    GRID_BAR();

    {
    PHASE_IDS();
    {
        float* PO = (float*)(ws + WS_PO); const float* PM = (const float*)(ws + WS_PM); const float* PL = (const float*)(ws + WS_PL);
        LAS float* oc = (LAS float*)(ldsl + wave * 2048);
        for (int it = vcu; it < DB * 8; it += G) {
            const int b = it >> 3, h = it & 7;
            float ms[2][8], ls[2][8]; f32x4 po[2][8];
#pragma unroll
            for (int q = 0; q < 2; ++q) { const int R = h * 16 + 2 * wave + q;
#pragma unroll
                for (int sp = 0; sp < 8; ++sp) { ms[q][sp] = PM[((size_t)b * 8 + sp) * 128 + R]; ls[q][sp] = PL[((size_t)b * 8 + sp) * 128 + R];
                    po[q][sp] = *(const f32x4*)(PO + (((size_t)b * 8 + sp) * 128 + R) * 256 + lane * 4); } }
#pragma unroll
            for (int q = 0; q < 2; ++q) { float M = -1e30f;
#pragma unroll
                for (int sp = 0; sp < 8; ++sp) M = fmaxf(M, ms[q][sp]);
                float L = 0.f; f32x4 a = (f32x4){0.f, 0.f, 0.f, 0.f};
#pragma unroll
                for (int sp = 0; sp < 8; ++sp) { const float wsc = __builtin_amdgcn_exp2f(ms[q][sp] - M); L += wsc * ls[q][sp]; a = a + po[q][sp] * wsc; }
                *(LAS f32x4*)(oc + q * 256 + lane * 4) = a * (1.0f / L); }
            asm volatile("s_waitcnt lgkmcnt(0)" ::: "memory");
            float acc0 = 0.f, acc1 = 0.f;
#pragma unroll 4
            for (int r = 0; r < 256; r += 4) {
                float wv[4];
#pragma unroll
                for (int q = 0; q < 4; ++q) wv[q] = w_uv[((size_t)(r + q) * 8 + h) * 64 + lane];
                const f32x4 o0 = *(const LAS f32x4*)(oc + r), o1 = *(const LAS f32x4*)(oc + 256 + r);
                acc0 += (o0[0] * wv[0] + o0[1] * wv[1]) + (o0[2] * wv[2] + o0[3] * wv[3]);
                acc1 += (o1[0] * wv[0] + o1[1] * wv[1]) + (o1[2] * wv[2] + o1[3] * wv[3]);
            }
            CAT[((size_t)MP + (size_t)b * DS + 2 * wave) * DM + h * 64 + lane] = (bf16_t)f2bf(acc0);
            CAT[((size_t)MP + (size_t)b * DS + 2 * wave + 1) * DM + h * 64 + lane] = (bf16_t)f2bf(acc1);
            asm volatile("s_waitcnt lgkmcnt(0)" ::: "memory");
        }
    }
    }
    GRID_BAR();

#if (PHMASK >> 6) & 1
    for (int rep_ = 0; rep_ <= ((DUPMASK >> 6) & 1); ++rep_)
    {
    PHASE_IDS();
    {
        pg8::Gemm g{CAT, WOUT, DM, DM}; pg8::StaticOrder S; S.init(MT, DM, DM, G, bx);
        pg8::EpiRes<false> E{x_prompt, x_sample, Y, X1B, SSQ2};
        pg8::gemm_phase<pg8::EpiRes<false>, pg8::StaticOrder>(ldsl, g, S, E);
    }
    }
#endif
    GRID_BAR();

#if (PHMASK >> 7) & 1
    for (int rep_ = 0; rep_ <= ((DUPMASK >> 7) & 1); ++rep_)
    {
    PHASE_IDS();
    {
        pg8::Gemm g{X1B, WUP, DM, DM}; pg8::StaticOrder S; S.init(MT, FF2, DM, G, bx);
        pg8::EpiUp E{ACT, HT, UPS, SSQ2, w_ffn_conv, b_ffn_conv, (LAS float*)(ldsl + LDS_HALO)};
        pg8::gemm_phase<pg8::EpiUp, pg8::StaticOrder>(ldsl, g, S, E);
    }
    }
#endif
    GRID_BAR();

#if (PHMASK >> 8) & 1
    for (int rep_ = 0; rep_ <= ((DUPMASK >> 8) & 1); ++rep_)
    {
    PHASE_IDS();
    {
#pragma unroll 4
        for (unsigned i = gt; i < (size_t)128 * 2 * FF; i += NGT) {
            const int c = (int)(i % FF), ri = (int)(i / FF), pm = ri >> 1, k = ri & 1;
            const bool first = (pm & 31) == 0;
            const float* h0 = HT + ((size_t)pm * 4) * FF2; const float* hp = HT + ((size_t)(pm - 1) * 4) * FF2;
            float res[2];
#pragma unroll
            for (int hb = 0; hb < 2; ++hb) { const int cc = hb * FF + c;
                const float cur = h0[(size_t)k * FF2 + cc];
                const float p1 = (k == 1) ? h0[cc] : (first ? 0.f : hp[(size_t)3 * FF2 + cc]);
                const float p2 = first ? 0.f : ((k == 1) ? hp[(size_t)3 * FF2 + cc] : hp[(size_t)2 * FF2 + cc]);
                res[hb] = b_ffn_conv[cc] + w_ffn_conv[cc] * p2 + w_ffn_conv[FF2 + cc] * p1 + w_ffn_conv[2 * FF2 + cc] * cur; }
            ACT[((size_t)pm * 256 + k) * FF + c] = (bf16_t)f2bf(gelu_tanh(res[0]) * res[1]);
        }
#pragma unroll 2
        for (unsigned i = gt; i < (size_t)MS * FF; i += NGT) {
            const int c = (int)(i % FF), ri = (int)(i / FF), b = ri >> 4, t = ri & 15;
            float res[2];
#pragma unroll
            for (int hb = 0; hb < 2; ++hb) { const int cc = hb * FF + c; float v = b_ffn_conv[cc];
#pragma unroll
                for (int k = 0; k < 3; ++k) { const int idx = t + k;
                    const float xv = (idx < 2) ? state_ffn_conv[((size_t)b * 2 + idx) * FF2 + cc] : UPS[((size_t)b * DS + idx - 2) * FF2 + cc];
                    v += w_ffn_conv[k * FF2 + cc] * xv; }
                res[hb] = v; }
            ACT[((size_t)MP + ri) * FF + c] = (bf16_t)f2bf(gelu_tanh(res[0]) * res[1]);
        }
        for (unsigned i = gt; i < (size_t)NB * 2 * FF2; i += NGT) { const int cc = (int)(i % FF2), k = (int)((i / FF2) & 1), b = (int)(i / (2 * FF2));
            out[O_PFFC + i] = HT[((size_t)(b * 32 + 31) * 4 + 2 + k) * FF2 + cc]; }
        for (unsigned i = gt; i < (size_t)DB * 2 * FF2; i += NGT) { const int cc = (int)(i % FF2), k = (int)((i / FF2) & 1), b = (int)(i / (2 * FF2));
            out[O_SFFC + i] = UPS[((size_t)b * DS + 14 + k) * FF2 + cc]; }
    }
    }
#endif
    GRID_BAR();

#if (PHMASK >> 9) & 1
    for (int rep_ = 0; rep_ <= ((DUPMASK >> 9) & 1); ++rep_)
    {
    PHASE_IDS();
    {
        pg8::Gemm g{ACT, WDN, FF, FF}; pg8::DownOrder S; S.S.init(MP, DM, FF, G, bx);
        pg8::EpiDown E{Y, (float*)(ws + WS_PART), X1B};
        pg8::gemm_phase<pg8::EpiDown, pg8::DownOrder>(ldsl, g, S, E);
    }
    }
#endif
    GRID_BAR();

#if (PHMASK >> 10) & 1
    for (int rep_ = 0; rep_ <= ((DUPMASK >> 10) & 1); ++rep_)
    {
    PHASE_IDS();
    for (int r = gw; r < MT; r += NGW) {
        f32x4* yr = (f32x4*)(Y + (size_t)r * DM) + lane;
        f32x4 v[4]; float s = 0.f;
        if (r < MP) {
#pragma unroll
            for (int j = 0; j < 4; ++j) v[j] = __builtin_nontemporal_load(&yr[64 * j]);
        } else {
#pragma unroll
            for (int j = 0; j < 4; ++j) { const u32x2 w = ((const u32x2*)(X1B + (size_t)r * DM))[lane + 64 * j]; v[j] = (f32x4){bflo(w.x), bfhi(w.x), bflo(w.y), bfhi(w.y)}; }
        }
        if (r >= MP) {
            for (int ks = 0; ks < 11; ++ks) { const f32x4* pr = (const f32x4*)((float*)(ws + WS_PART) + ((size_t)ks * MS + (r - MP)) * DM) + lane;
#pragma unroll
                for (int j = 0; j < 4; ++j) v[j] = v[j] + pr[64 * j]; } }
#pragma unroll
        for (int j = 0; j < 4; ++j) s += (v[j][0] * v[j][0] + v[j][1] * v[j][1]) + (v[j][2] * v[j][2] + v[j][3] * v[j][3]);
        const float rs = 1.0f / sqrtf(wave_sum(s) * (1.0f / DM) + EPS);
#pragma unroll
        for (int j = 0; j < 4; ++j) { const f32x4 gv = ((const f32x4*)final_norm_g)[lane + 64 * j]; __builtin_nontemporal_store(v[j] * rs * gv, &yr[64 * j]); }
    }
    }
#endif
}

#undef ws
#undef out
#undef Y
extern "C" void kernel_launch(void* const* d_in, const int* in_sizes, int n_in, void* d_out, int out_size, void* d_ws, size_t ws_size, hipStream_t stream) {
    static int grid = 0;
    if (grid == 0) {
        if (n_in != 28 || ws_size < WS_END) { fprintf(stderr, "kernel_launch: unexpected n_in %d / ws_size %zu (need %zu)\n", n_in, ws_size, (size_t)WS_END); grid = -1; return; }
        int dev = 0, cus = 0, per_cu = 0;
        hipGetDevice(&dev); hipDeviceGetAttribute(&cus, hipDeviceAttributeMultiprocessorCount, dev);
        if (hipFuncSetAttribute((const void*)fwd_megakernel, hipFuncAttributeMaxDynamicSharedMemorySize, LDS_BYTES) != hipSuccess) { fprintf(stderr, "kernel_launch: hipFuncSetAttribute failed\n"); grid = -1; return; }
        hipOccupancyMaxActiveBlocksPerMultiprocessor(&per_cu, (const void*)fwd_megakernel, 512, LDS_BYTES);
        (void)hipGetLastError();
        if (per_cu < 1) per_cu = 1;
        grid = cus;
    }
    if (grid < 0) return;
    if (hipMemsetAsync((char*)d_ws + WS_BAR, 0, XCD_BAR_WORDS * 4, stream) != hipSuccess) { fprintf(stderr, "kernel_launch: memset failed\n"); return; }
    Args a{};
    for (int i = 0; i < 28; ++i) a.in[i] = (const float*)d_in[i];
    a.out = (float*)d_out; a.ws = (unsigned char*)d_ws;
    void* args[] = {&a};
    hipError_t e = hipLaunchCooperativeKernel((const void*)fwd_megakernel, dim3(grid), dim3(512), args, LDS_BYTES, stream);
    if (e != hipSuccess) fprintf(stderr, "cooperative launch failed: %s (grid %d)\n", hipGetErrorString(e), grid);
}
```

```cpp
#include <hip/hip_runtime.h>
#include <hip/hip_cooperative_groups.h>
#include <cstdio>
#include <cstdint>
namespace cg = cooperative_groups;

#define LAS __attribute__((address_space(3)))
typedef unsigned short bf16_t;
typedef short bf16x8 __attribute__((ext_vector_type(8)));
typedef short s16x4 __attribute__((ext_vector_type(4)));
typedef float f32x2 __attribute__((ext_vector_type(2)));
typedef float f32x4 __attribute__((ext_vector_type(4)));
typedef float f32x16 __attribute__((ext_vector_type(16)));
typedef unsigned u32x2 __attribute__((ext_vector_type(2)));
typedef unsigned u32x4 __attribute__((ext_vector_type(4)));

constexpr int DM = 1024, NB = 4, SEQ = 8192, DB = 32, DS = 16, PAST = 2048;
constexpr int MP = NB * SEQ;
constexpr int MS = DB * DS;
constexpr int MT = MP + MS;
constexpr int QL = 384, KVL = 256, ROPE = 32, RGW = 512, FF = 2816, FF2 = 5632;
constexpr int NIN = 1792;
constexpr int NQ = 768;
constexpr float EPS = 1e-6f;
constexpr float QSCALE = 0.10206207261596577f * 1.4426950408889634f;
constexpr int C_CQ = 0, C_CKV = 384, C_RGX = 640, C_RGG = 1152, C_KR = 1664;

constexpr size_t O_Y = 0, O_PCKV = 34078720, O_PKR = 42467328, O_PRGH = 43515904, O_PRGC = 43517952, O_PFFC = 43524096,
                 O_SCKV = 43569152, O_SKR = 43700224, O_SRGH = 43716608, O_SRGC = 43732992, O_SFFC = 43782144;

constexpr size_t MiB = 1u << 20;
constexpr size_t WS_SP = 0;
constexpr size_t WS_BAR = 16 * 1024;
constexpr size_t WS_SA = 64 * 1024;
constexpr size_t WS_SU = WS_SA + 512 * 1024;
constexpr size_t WS_ROPE = 2 * MiB;
constexpr size_t WS_SSQ2 = 3 * MiB;
constexpr size_t WS_SSQ3 = 6 * MiB;
constexpr size_t WS_WIN = 9 * MiB;
constexpr size_t WS_WUQ = 13 * MiB;
constexpr size_t WS_WKV = 14 * MiB;
constexpr size_t WS_WRG = 15 * MiB;
constexpr size_t WS_WOUT = 16 * MiB;
constexpr size_t WS_WUP = 18 * MiB;
constexpr size_t WS_WDN = 29 * MiB;
constexpr size_t WS_S1 = 36 * MiB;
constexpr size_t WS_XN = WS_S1;
constexpr size_t WS_PROJ = WS_S1 + 66 * MiB;
constexpr size_t WS_KV = WS_S1;
constexpr size_t WS_PO = WS_S1 + 100 * MiB;
constexpr size_t WS_PM = WS_S1 + 140 * MiB;
constexpr size_t WS_PL = WS_S1 + 141 * MiB;
constexpr size_t WS_ACT = WS_S1;
constexpr size_t WS_S2 = WS_S1 + 200 * MiB;
constexpr size_t WS_CQN = WS_S2;
constexpr size_t WS_XC = WS_S2 + 25 * MiB;
constexpr size_t WS_CKVN = WS_S2 + 58 * MiB;
constexpr size_t WS_CAT = WS_S2;
constexpr size_t WS_HT = WS_S2 + 66 * MiB;
constexpr size_t WS_UPS = WS_S2 + 78 * MiB;
constexpr size_t WS_S3 = WS_S2 + 108 * MiB;
constexpr size_t WS_LA = WS_S3;
constexpr size_t WS_KR = WS_S3 + 65 * MiB;
constexpr size_t WS_X1B = WS_S3;
constexpr size_t WS_PART = WS_S2;
constexpr size_t WS_END = WS_S3 + 72 * MiB;
constexpr size_t YS_Q = 0;
constexpr size_t YS_GG = 50 * MiB;
constexpr size_t YS_U = 83 * MiB;

#ifndef P3SEL
#define P3SEL 7
#endif
#ifndef SAMPLE_REP
#define SAMPLE_REP 1
#endif
#ifndef RG_REP
#define RG_REP 1
#endif
#ifndef DUPMASK
#define DUPMASK 0
#endif
#ifndef PHMASK
#define PHMASK 0x7ff
#endif
constexpr int LDS_STAGE = 131072, LDS_HALO = 131072, LDS_BYTES = 147456;

typedef __bf16 bf16x2_hw __attribute__((ext_vector_type(2)));
__device__ __forceinline__ unsigned pk2(float lo, float hi) { const f32x2 v = {lo, hi}; return __builtin_bit_cast(unsigned, __builtin_convertvector(v, bf16x2_hw)); }
__device__ __forceinline__ unsigned f2bf(float f) { return pk2(f, 0.f) & 0xffffu; }
__device__ __forceinline__ float bflo(unsigned w) { return __builtin_bit_cast(float, w << 16); }
__device__ __forceinline__ float bfhi(unsigned w) { return __builtin_bit_cast(float, w & 0xffff0000u); }
__device__ __forceinline__ float bf2f(bf16_t h) { return __builtin_bit_cast(float, (unsigned)h << 16); }
__device__ __forceinline__ float wave_sum(float v) {
#pragma unroll
    for (int o = 1; o < 64; o <<= 1) v += __shfl_xor(v, o);
    return v;
}
__device__ __forceinline__ float fexp(float x) { return __builtin_amdgcn_exp2f(x * 1.4426950408889634f); }
__device__ __forceinline__ float sigmoidf_(float x) { return __builtin_amdgcn_rcpf(1.0f + __builtin_amdgcn_exp2f(-1.4426950408889634f * x)); }
__device__ __forceinline__ float gelu_tanh(float x) {
    const float t = x * (1.0f + 0.044715f * x * x);
    return x * __builtin_amdgcn_rcpf(1.0f + __builtin_amdgcn_exp2f(-2.3022082f * t));
}
__device__ __forceinline__ int tok_pos(int r) { return r < MP ? (r & (SEQ - 1)) : PAST + ((r - MP) & (DS - 1)); }

namespace pg8 {
constexpr int BM = 256, BK = 64, HALF = 128, HTB = HALF * BK * 2, STAGE_BYTES = 8 * HTB, NXCD = 8, WGM = 8;
__host__ __device__ __forceinline__ int lds_byte(int r, int c) { const int st = (r >> 4) * 2 + (c >> 5), rr = r & 15, cc = c & 31, ob = rr * 64 + cc * 2; return st * 1024 + (ob ^ (((ob >> 9) & 1) << 5)); }
__host__ __device__ __forceinline__ void stage_rc(int b, int& R, int& C) { const int st = b / 1024, sb = b % 1024, swz = sb ^ (((sb >> 9) & 1) << 5); R = (st >> 1) * 16 + swz / 64; C = (st & 1) * 32 + (swz % 64) / 2; }
__host__ __device__ __forceinline__ int perm32(int rho) { const int n = rho >> 4, i = rho & 15; return 8 * (i >> 2) + 4 * n + (i & 3); }
struct Unit { int pm, pn, kofs, nt; };
struct Gemm { const bf16_t* A; const bf16_t* Bt; int lda, ldb; };
struct StaticOrder {
    int nM, nN, nwg, G, c, nt;
    __host__ __device__ void init(int M, int N, int K, int G_, int c_) { nM = M / BM; nN = N / BM; nwg = nM * nN; G = G_; c = c_; nt = K / BK; }
    __host__ __device__ void map(int wgid, Unit& u) const {
        { const int q = nwg / NXCD, r = nwg % NXCD, xcd = wgid % NXCD, off = wgid / NXCD; wgid = (xcd < r ? xcd * (q + 1) : r * (q + 1) + (xcd - r) * q) + off; }
        const int nig = WGM * nN, gid = wgid / nig, fm = gid * WGM, gsz = (nM - fm) < WGM ? (nM - fm) : WGM;
        u.pm = fm + ((wgid % nig) % gsz); u.pn = (wgid % nig) / gsz; u.kofs = 0; u.nt = nt;
    }
    __host__ __device__ bool next(int i, Unit& u) const {
        const long L = (long)i * G + c; if (L >= nwg) return false;
        map((int)L, u); return true;
    }
};
struct RgOrder {
    StaticOrder S;
    __host__ __device__ bool next(int i, Unit& u) const { if (!S.next(i, u)) return false; u.kofs = 128 * u.pn; int n2 = 2; asm volatile("" : "+s"(n2)); u.nt = n2; return true; }
};
struct DownOrder {
    StaticOrder S;
    __host__ __device__ bool next(int i, Unit& u) const {
        const long L = (long)i * S.G + S.c;
        if (L < S.nwg) { S.map((int)L, u); return true; }
        const int v = (int)(L - S.nwg); if (v >= 88) return false;
        const int ks = v % 11, t = v / 11; u.pm = S.nM + (t >> 2); u.pn = t & 3; u.kofs = ks * 256; u.nt = 4; return true;
    }
};
struct UpOrder {
    StaticOrder S;
    __host__ __device__ bool next(int i, Unit& u) const {
        const long L = (long)i * S.G + S.c;
        if (L < S.nwg) { S.map((int)L, u); return true; }
        const int v = (int)(L - S.nwg); if (v >= 176) return false;
        const int ks = v & 3, t = v >> 2; u.pm = S.nM + t / 22; u.pn = t % 22; u.kofs = ks * 256; u.nt = 4; return true;
    }
};
typedef __bf16 bf16x2_t __attribute__((ext_vector_type(2)));
__device__ __forceinline__ unsigned cvt_pk_bf16(float lo, float hi) { const f32x2 v = {lo, hi}; return __builtin_bit_cast(unsigned, __builtin_convertvector(v, bf16x2_t)); }

typedef f32x4 Acc[2][2][4][2];

template <class Epi, class Sched, bool ALIGN_EPI = true>
__device__ __forceinline__ void gemm_phase(LAS unsigned char* lds, const Gemm g, const Sched& S, const Epi& E) {
    int tid = threadIdx.x; asm volatile("" : "+v"(tid));
    const int wid = __builtin_amdgcn_readfirstlane(tid >> 6), lane = tid & 63, wr = wid >> 2, wc = wid & 3, fr = lane & 15, fq = lane >> 4;
    unsigned voffA[2], voffB[2];
#pragma unroll
    for (int i = 0; i < 2; ++i) { int R, C; stage_rc(tid * 16 + i * 8192, R, C); const int Rb = Epi::PERM ? ((R & ~31) + perm32(R & 31)) : R;
        voffA[i] = (unsigned)(R * g.lda + C) * 2u; voffB[i] = (unsigned)(Rb * g.ldb + C) * 2u; }
    const size_t kstep = (size_t)(BK * 2);
    const size_t hstepA = (size_t)HALF * g.lda * 2, hstepB = (size_t)HALF * g.ldb * 2;
    const unsigned ldsw = (unsigned)wid * 1024u;
    const int aoff = lds_byte(wr * 64 + fr, fq * 8), boff = lds_byte(wc * 32 + fr, fq * 8);
#define PG8_SA(b, h) (((b) * 2 + (h)) * HTB)
#define PG8_SB(b, h) ((4 + (b) * 2 + (h)) * HTB)
#define PG8_STAGE(bufoff, gbase, voff) do { _Pragma("unroll") for (int _i = 0; _i < 2; ++_i) \
        __builtin_amdgcn_global_load_lds((const unsigned*)((const char*)(gbase) + (voff)[_i]), (LAS unsigned*)(lds + (bufoff) + ldsw + _i * 8192), 16, 0, 0); } while (0)
#define PG8_LDA(dst, b, h) do { _Pragma("unroll") for (int m = 0; m < 4; ++m) _Pragma("unroll") for (int k = 0; k < 2; ++k) dst[m][k] = *(const LAS bf16x8*)(lds + PG8_SA(b, h) + aoff + m * 2048 + k * 1024); } while (0)
#define PG8_LDB(dst, b, h) do { _Pragma("unroll") for (int n = 0; n < 2; ++n) _Pragma("unroll") for (int k = 0; k < 2; ++k) dst[n][k] = *(const LAS bf16x8*)(lds + PG8_SB(b, h) + boff + n * 2048 + k * 1024); } while (0)
#define PG8_MMA(ai, bj, At, Bt) do { __builtin_amdgcn_s_setprio(1); _Pragma("unroll") for (int m = 0; m < 4; ++m) _Pragma("unroll") for (int n = 0; n < 2; ++n) _Pragma("unroll") for (int k = 0; k < 2; ++k) \
        acc[ai][bj][m][n] = __builtin_amdgcn_mfma_f32_16x16x32_bf16(Bt[n][k], At[m][k], acc[ai][bj][m][n], 0, 0, 0); __builtin_amdgcn_s_setprio(0); } while (0)
#define PG8_WAIT_V(n) asm volatile("s_waitcnt vmcnt(" #n ")" ::: "memory")
#define PG8_WAIT_L(n) asm volatile("s_waitcnt lgkmcnt(" #n ")" ::: "memory")
#define PG8_BAR __builtin_amdgcn_s_barrier()
#define PG8_SCHED __builtin_amdgcn_sched_barrier(0)
    Unit cur, nxt; int ui = 0;
    if (!S.next(0, cur)) return;
    Acc acc;
#pragma unroll
    for (int a = 0; a < 2; ++a)
#pragma unroll
        for (int b = 0; b < 2; ++b)
#pragma unroll
            for (int m = 0; m < 4; ++m)
#pragma unroll
                for (int n = 0; n < 2; ++n) acc[a][b][m][n] = (f32x4){0.f, 0.f, 0.f, 0.f};
    bf16x8 At[4][2], B0[2][2], B1[2][2];
    const char* cA = (const char*)g.A + ((size_t)cur.pm * 2 * hstepA + (size_t)cur.kofs * 2); const char* cB = (const char*)g.Bt + ((size_t)cur.pn * 2 * hstepB + (size_t)cur.kofs * 2);
    PG8_STAGE(PG8_SB(0, 0), cB, voffB); PG8_STAGE(PG8_SB(0, 1), cB + hstepB, voffB); PG8_STAGE(PG8_SA(0, 0), cA, voffA); PG8_STAGE(PG8_SA(0, 1), cA + hstepA, voffA);
    if (wr == 1) PG8_BAR;
    PG8_WAIT_V(2); PG8_BAR;
    PG8_STAGE(PG8_SB(1, 0), cB + kstep, voffB); PG8_STAGE(PG8_SA(1, 0), cA + kstep, voffA); PG8_STAGE(PG8_SB(1, 1), cB + hstepB + kstep, voffB);
    PG8_WAIT_V(6); PG8_BAR;
    for (;;) {
        const bool has_next = S.next(ui + 1, nxt);
        const char* nA = has_next ? (const char*)g.A + ((size_t)nxt.pm * 2 * hstepA + (size_t)nxt.kofs * 2) : cA; const char* nB = has_next ? (const char*)g.Bt + ((size_t)nxt.pn * 2 * hstepB + (size_t)nxt.kofs * 2) : cB;
        const int nt = cur.nt;
        for (int t = 0; t < nt; t += 2) {
            const bool last = (t == nt - 2);
            const char* a1 = cA + (size_t)(t + 1) * kstep;
            const char* a2 = last ? nA : cA + (size_t)(t + 2) * kstep; const char* b2 = last ? nB : cB + (size_t)(t + 2) * kstep;
            const char* a3 = a2 + kstep; const char* b3 = b2 + kstep;
            PG8_LDB(B0, 0, 0); PG8_LDB(B1, 0, 1); PG8_SCHED; PG8_LDA(At, 0, 0); PG8_STAGE(PG8_SA(1, 1), a1 + hstepA, voffA);
            PG8_WAIT_V(8); PG8_WAIT_L(0); PG8_BAR; PG8_MMA(0, 0, At, B0); PG8_MMA(0, 1, At, B1); PG8_BAR; PG8_SCHED;
            PG8_LDA(At, 0, 1); PG8_STAGE(PG8_SB(0, 0), b2, voffB); PG8_STAGE(PG8_SB(0, 1), b2 + hstepB, voffB); PG8_STAGE(PG8_SA(0, 0), a2, voffA);
            PG8_WAIT_V(8); PG8_WAIT_L(0); PG8_BAR; PG8_MMA(1, 0, At, B0); PG8_MMA(1, 1, At, B1); PG8_BAR; PG8_SCHED;
            PG8_LDB(B0, 1, 0); PG8_LDB(B1, 1, 1); PG8_SCHED; PG8_LDA(At, 1, 0); PG8_STAGE(PG8_SA(0, 1), a2 + hstepA, voffA);
            PG8_WAIT_V(8); PG8_WAIT_L(0); PG8_BAR; PG8_MMA(0, 0, At, B0); PG8_MMA(0, 1, At, B1); PG8_BAR; PG8_SCHED;
            PG8_LDA(At, 1, 1); PG8_STAGE(PG8_SB(1, 0), b3, voffB); PG8_STAGE(PG8_SB(1, 1), b3 + hstepB, voffB); PG8_STAGE(PG8_SA(1, 0), a3, voffA);
            PG8_WAIT_V(8); PG8_WAIT_L(0); PG8_BAR; PG8_MMA(1, 0, At, B0); PG8_MMA(1, 1, At, B1); PG8_BAR; PG8_SCHED;
        }
        if constexpr (ALIGN_EPI) { if (wr == 0) PG8_BAR; }
        { int fr2 = fr, fq2 = fq; asm volatile("" : "+v"(fr2), "+v"(fq2)); E(acc, cur, wr, wc, fr2, fq2); }
        if (!has_next) break;
#pragma unroll
        for (int a = 0; a < 2; ++a)
#pragma unroll
            for (int b = 0; b < 2; ++b)
#pragma unroll
                for (int m = 0; m < 4; ++m)
#pragma unroll
                    for (int n = 0; n < 2; ++n) acc[a][b][m][n] = (f32x4){0.f, 0.f, 0.f, 0.f};
        cur = nxt; cA = nA; cB = nB; ++ui;
        if constexpr (ALIGN_EPI) { if (wr == 1) PG8_BAR; }
    }
    PG8_WAIT_V(0);
    if constexpr (!ALIGN_EPI) { if (wr == 0) PG8_BAR; }
    PG8_BAR;
#undef PG8_SA
#undef PG8_SB
#undef PG8_STAGE
#undef PG8_LDA
#undef PG8_LDB
#undef PG8_MMA
#undef PG8_WAIT_V
#undef PG8_WAIT_L
#undef PG8_BAR
#undef PG8_SCHED
}

template <bool KVMAP> struct EpiStore {
    static constexpr bool PERM = true;
    bf16_t* O; int ldc;
    __device__ __forceinline__ void operator()(Acc& acc, const Unit& u, int wr, int wc, int fr, int fq) const {
        const int row0 = u.pm * BM + wr * 64 + fr; const int col0 = u.pn * BM + wc * 32 + 8 * fq;
#pragma unroll
        for (int ai = 0; ai < 2; ++ai)
#pragma unroll
            for (int m = 0; m < 4; ++m) {
                int row = row0 + ai * HALF + m * 16;
                bf16_t* rowp = O + (size_t)row * ldc + col0;
#pragma unroll
                for (int bj = 0; bj < 2; ++bj) { const f32x4 v0 = acc[ai][bj][m][0], v1 = acc[ai][bj][m][1];
                    u32x4 w; w.x = cvt_pk_bf16(v0[0], v0[1]); w.y = cvt_pk_bf16(v0[2], v0[3]); w.z = cvt_pk_bf16(v1[0], v1[1]); w.w = cvt_pk_bf16(v1[2], v1[3]);
                    *(u32x4*)(rowp + bj * HALF) = w; } }
    }
};
struct EpiQ {
    static constexpr bool PERM = false;
    bf16_t* Q; const f32x2* rope;
    __device__ __forceinline__ void operator()(Acc& acc, const Unit& u, int wr, int wc, int fr, int fq) const {
        const int row0 = u.pm * BM + wr * 64 + fr;
#pragma unroll
        for (int ai = 0; ai < 2; ++ai)
#pragma unroll
            for (int m = 0; m < 4; ++m) {
                const int row = row0 + ai * HALF + m * 16; const int pos = tok_pos(row);
                const f32x4* cs = (const f32x4*)(rope + (size_t)pos * 16 + 4 * fq);
#pragma unroll
                for (int bj = 0; bj < 2; ++bj) {
                    const int g = u.pn * 8 + bj * 4 + wc;
                    f32x4 v0 = acc[ai][bj][m][0], v1 = acc[ai][bj][m][1];
                    if (g % 3 == 2) { const f32x4 c01 = cs[0], c23 = cs[1];
                        const float c[4] = {c01[0], c01[2], c23[0], c23[2]}, s[4] = {c01[1], c01[3], c23[1], c23[3]};
#pragma unroll
                        for (int e = 0; e < 4; ++e) { const float x1 = v0[e], x2 = v1[e]; v0[e] = x1 * c[e] - x2 * s[e]; v1[e] = x2 * c[e] + x1 * s[e]; } }
                    v0 = v0 * QSCALE; v1 = v1 * QSCALE;
                    bf16_t* p = Q + (size_t)row * NQ + u.pn * BM + bj * HALF + wc * 32 + 4 * fq;
                    u32x2 w0, w1; w0.x = cvt_pk_bf16(v0[0], v0[1]); w0.y = cvt_pk_bf16(v0[2], v0[3]); w1.x = cvt_pk_bf16(v1[0], v1[1]); w1.y = cvt_pk_bf16(v1[2], v1[3]);
                    *(u32x2*)p = w0; *(u32x2*)(p + 16) = w1; }
                asm volatile("" ::: "memory"); }
    }
};
struct EpiRG {
    static constexpr bool PERM = true;
    const bf16_t* xc; const float* ba; const float* bi; const float* sp; _Float16* la; bf16_t* uo;
    __device__ __forceinline__ void operator()(Acc& acc, const Unit& u, int wr, int wc, int fr, int fq) const {
        const int row0 = u.pm * BM + wr * 64 + fr; const int ch0 = u.pn * HALF + wc * 32 + 8 * fq;
#pragma unroll
        for (int n = 0; n < 2; ++n) {
            const f32x4 vba = *(const f32x4*)(ba + ch0 + 4 * n), vbi = *(const f32x4*)(bi + ch0 + 4 * n), vsp = *(const f32x4*)(sp + ch0 + 4 * n);
#pragma unroll
            for (int ai = 0; ai < 2; ++ai) {
                u32x2 xwv[4];
#pragma unroll
                for (int m = 0; m < 4; ++m) xwv[m] = *(const u32x2*)(xc + (size_t)(row0 + ai * HALF + m * 16) * RGW + ch0 + 4 * n);
#pragma unroll
                for (int m = 0; m < 4; ++m) {
                    const int row = row0 + ai * HALF + m * 16;
                    const u32x2 xw = xwv[m];
                    const float xv[4] = {bflo(xw.x), bfhi(xw.x), bflo(xw.y), bfhi(xw.y)};
                    f32x4 lo; float uu[4];
#pragma unroll
                    for (int e = 0; e < 4; ++e) {
                        const float r = sigmoidf_(acc[ai][0][m][n][e] + vba[e]), ig = sigmoidf_(acc[ai][1][m][n][e] + vbi[e]);
                        const float l = -8.0f * r * vsp[e];
                        lo[e] = l; uu[e] = __builtin_amdgcn_sqrtf(1.0f - __builtin_amdgcn_exp2f(2.8853900817779268f * l)) * (ig * xv[e]); }
                    { typedef _Float16 h4 __attribute__((ext_vector_type(4))); h4 lh; lh[0] = (_Float16)(lo[0] * 256.0f); lh[1] = (_Float16)(lo[1] * 256.0f); lh[2] = (_Float16)(lo[2] * 256.0f); lh[3] = (_Float16)(lo[3] * 256.0f);
                      *(h4*)(la + (size_t)row * RGW + ch0 + 4 * n) = lh; }
                    u32x2 w; w.x = cvt_pk_bf16(uu[0], uu[1]); w.y = cvt_pk_bf16(uu[2], uu[3]);
                    *(u32x2*)(uo + (size_t)row * RGW + ch0 + 4 * n) = w; }
                asm volatile("" ::: "memory"); } }
    }
};
template <bool INPLACE> struct EpiRes {
    static constexpr bool PERM = false;
    const float* xp; const float* xs; float* Y; bf16_t* xb; float* ssq;
    __device__ __forceinline__ void operator()(Acc& acc, const Unit& u, int wr, int wc, int fr, int fq) const {
        const int row0 = u.pm * BM + wr * 64 + fr; const int col0 = u.pn * BM + wc * 32 + 4 * fq;
#pragma unroll
        for (int ai = 0; ai < 2; ++ai) {
            f32x4 res[4][2][2];
#pragma unroll
            for (int m = 0; m < 4; ++m) { const int row = row0 + ai * HALF + m * 16;
                const float* rp = INPLACE ? (Y + (size_t)row * DM) : (row < MP ? xp + (size_t)row * DM : xs + (size_t)(row - MP) * DM);
#pragma unroll
                for (int bj = 0; bj < 2; ++bj)
#pragma unroll
                    for (int n = 0; n < 2; ++n) res[m][bj][n] = __builtin_nontemporal_load((const f32x4*)(rp + col0 + bj * HALF + n * 16)); }
#pragma unroll
            for (int m = 0; m < 4; ++m) { const int row = row0 + ai * HALF + m * 16; float ss = 0.f;
#pragma unroll
                for (int bj = 0; bj < 2; ++bj)
#pragma unroll
                    for (int n = 0; n < 2; ++n) { const int col = col0 + bj * HALF + n * 16;
                        const f32x4 v = res[m][bj][n] + acc[ai][bj][m][n];
                        if (INPLACE) *(f32x4*)(Y + (size_t)row * DM + col) = v;
                        if (!INPLACE) { u32x2 w; w.x = cvt_pk_bf16(v[0], v[1]); w.y = cvt_pk_bf16(v[2], v[3]); *(u32x2*)(xb + (size_t)row * DM + col) = w; }
                        ss += (v[0] * v[0] + v[1] * v[1]) + (v[2] * v[2] + v[3] * v[3]); }
                ss += __shfl_xor(ss, 16); ss += __shfl_xor(ss, 32);
                if (fq == 0) ssq[(size_t)row * 16 + u.pn * 4 + wc] = ss; }
            asm volatile("" ::: "memory"); }
    }
};
struct EpiDown {
    static constexpr bool PERM = false;
    float* Y; float* PART; const bf16_t* xb;
    __device__ __forceinline__ void operator()(Acc& acc, const Unit& u, int wr, int wc, int fr, int fq) const {
        const int row0 = u.pm * BM + wr * 64 + fr; const int col0 = u.pn * BM + wc * 32 + 4 * fq;
        if (u.pm >= MP / BM) {
            float* pb = PART + (size_t)(u.kofs >> 8) * MS * DM;
#pragma unroll
            for (int ai = 0; ai < 2; ++ai)
#pragma unroll
                for (int m = 0; m < 4; ++m) { float* rp = pb + (size_t)(row0 + ai * HALF + m * 16 - MP) * DM + col0;
#pragma unroll
                    for (int bj = 0; bj < 2; ++bj)
#pragma unroll
                        for (int n = 0; n < 2; ++n) *(f32x4*)(rp + bj * HALF + n * 16) = acc[ai][bj][m][n]; }
            return; }
#pragma unroll
        for (int ai = 0; ai < 2; ++ai) {
            u32x2 res[4][2][2];
#pragma unroll
            for (int m = 0; m < 4; ++m) { const bf16_t* rp = xb + (size_t)(row0 + ai * HALF + m * 16) * DM + col0;
#pragma unroll
                for (int bj = 0; bj < 2; ++bj)
#pragma unroll
                    for (int n = 0; n < 2; ++n) res[m][bj][n] = __builtin_nontemporal_load((const u32x2*)(rp + bj * HALF + n * 16)); }
#pragma unroll
            for (int m = 0; m < 4; ++m) { float* rp = Y + (size_t)(row0 + ai * HALF + m * 16) * DM + col0;
#pragma unroll
                for (int bj = 0; bj < 2; ++bj)
#pragma unroll
                    for (int n = 0; n < 2; ++n) { const u32x2 w = res[m][bj][n];
                        *(f32x4*)(rp + bj * HALF + n * 16) = (f32x4){bflo(w.x), bfhi(w.x), bflo(w.y), bfhi(w.y)} + acc[ai][bj][m][n]; } }
            asm volatile("" ::: "memory"); }
    }
};
__device__ __forceinline__ float dpp_prev1(float cur, float prev) {
    const int t = __builtin_amdgcn_update_dpp(0, __builtin_bit_cast(int, cur), 0x111, 0xf, 0xf, true);
    return __builtin_bit_cast(float, __builtin_amdgcn_update_dpp(t, __builtin_bit_cast(int, prev), 0x10F, 0xf, 0xf, false));
}
__device__ __forceinline__ float dpp_prev2(float cur, float prev) {
    const int t = __builtin_amdgcn_update_dpp(0, __builtin_bit_cast(int, cur), 0x112, 0xf, 0xf, true);
    return __builtin_bit_cast(float, __builtin_amdgcn_update_dpp(t, __builtin_bit_cast(int, prev), 0x10E, 0xf, 0xf, false));
}
struct EpiUp {
    static constexpr bool PERM = true;
    bf16_t* act; float* HT; float* UPS; const float* ssq2; const float* cw; const float* cb; LAS float* halo;
    __device__ __forceinline__ void operator()(Acc& acc, const Unit& u, int wr, int wc, int fr, int fq) const {
        const int row0 = u.pm * BM + wr * 64 + fr; const int cl = wc * 32 + 8 * fq;
#pragma unroll
        for (int ai = 0; ai < 2; ++ai) {
            f32x4 sq[4][4];
#pragma unroll
            for (int m = 0; m < 4; ++m) { const f32x4* sp = (const f32x4*)(ssq2 + (size_t)(row0 + ai * HALF + m * 16) * 16);
#pragma unroll
                for (int q = 0; q < 4; ++q) sq[m][q] = sp[q]; }
#pragma unroll
            for (int m = 0; m < 4; ++m) {
                const f32x4 t = (sq[m][0] + sq[m][1]) + (sq[m][2] + sq[m][3]);
                const float rs = __builtin_amdgcn_rsqf(((t[0] + t[1]) + (t[2] + t[3])) * (1.0f / DM) + EPS);
#pragma unroll
                for (int bj = 0; bj < 2; ++bj)
#pragma unroll
                    for (int n = 0; n < 2; ++n) acc[ai][bj][m][n] = acc[ai][bj][m][n] * rs; }
            asm volatile("" ::: "memory"); }
        if (u.pm >= MP / BM) {
#pragma unroll
            for (int ai = 0; ai < 2; ++ai)
#pragma unroll
                for (int m = 0; m < 4; ++m) { const int srow = row0 + ai * HALF + m * 16 - MP;
#pragma unroll
                    for (int bj = 0; bj < 2; ++bj)
#pragma unroll
                        for (int n = 0; n < 2; ++n) *(f32x4*)(UPS + (size_t)srow * FF2 + bj * FF + u.pn * HALF + cl + 4 * n) = acc[ai][bj][m][n]; }
            return; }
        if (fr >= 14) {
#pragma unroll
            for (int ai = 0; ai < 2; ++ai) { const int s = ai * 2 + wr;
#pragma unroll
                for (int bj = 0; bj < 2; ++bj)
#pragma unroll
                    for (int n = 0; n < 2; ++n) *(LAS f32x4*)(halo + ((s * 2 + (fr - 14)) * 2 + bj) * HALF + cl + 4 * n) = acc[ai][bj][3][n]; }
            if (wr == 1) {
#pragma unroll
                for (int bj = 0; bj < 2; ++bj)
#pragma unroll
                    for (int n = 0; n < 2; ++n) *(f32x4*)(HT + ((size_t)u.pm * 4 + 2 + (fr - 14)) * FF2 + bj * FF + u.pn * HALF + cl + 4 * n) = acc[1][bj][3][n]; }
        }
        if (fr < 2 && wr == 0) {
#pragma unroll
            for (int bj = 0; bj < 2; ++bj)
#pragma unroll
                for (int n = 0; n < 2; ++n) *(f32x4*)(HT + ((size_t)u.pm * 4 + fr) * FF2 + bj * FF + u.pn * HALF + cl + 4 * n) = acc[0][bj][0][n];
        }
        asm volatile("s_waitcnt lgkmcnt(0)" ::: "memory"); __builtin_amdgcn_s_barrier(); asm volatile("" ::: "memory");
#pragma unroll
        for (int n = 0; n < 2; ++n) {
            const int col = u.pn * HALF + cl + 4 * n;
            const f32x4 w0a = *(const f32x4*)(cw + col), w1a = *(const f32x4*)(cw + FF2 + col), w2a = *(const f32x4*)(cw + 2 * FF2 + col), bba = *(const f32x4*)(cb + col);
            const f32x4 w0b = *(const f32x4*)(cw + FF + col), w1b = *(const f32x4*)(cw + FF2 + FF + col), w2b = *(const f32x4*)(cw + 2 * FF2 + FF + col), bbb = *(const f32x4*)(cb + FF + col);
#pragma unroll
            for (int ai = 0; ai < 2; ++ai) {
                const int s = ai * 2 + wr;
                f32x4 ha = (f32x4){0.f, 0.f, 0.f, 0.f}, hb = ha;
                if (s > 0 && fr >= 14) { ha = *(const LAS f32x4*)(halo + (((s - 1) * 2 + (fr - 14)) * 2 + 0) * HALF + cl + 4 * n);
                                          hb = *(const LAS f32x4*)(halo + (((s - 1) * 2 + (fr - 14)) * 2 + 1) * HALF + cl + 4 * n); }
#pragma unroll
                for (int m = 0; m < 4; ++m) {
                    const f32x4 ca = acc[ai][0][m][n], cbv = acc[ai][1][m][n];
                    const f32x4 pa = (m > 0) ? acc[ai][0][m > 0 ? m - 1 : 0][n] : ha, pb = (m > 0) ? acc[ai][1][m > 0 ? m - 1 : 0][n] : hb;
                    float res[4];
#pragma unroll
                    for (int e = 0; e < 4; ++e) {
                        const float a1 = dpp_prev1(ca[e], pa[e]), a2 = dpp_prev2(ca[e], pa[e]);
                        const float b1 = dpp_prev1(cbv[e], pb[e]), b2 = dpp_prev2(cbv[e], pb[e]);
                        const float ua = bba[e] + w0a[e] * a2 + w1a[e] * a1 + w2a[e] * ca[e];
                        const float ub = bbb[e] + w0b[e] * b2 + w1b[e] * b1 + w2b[e] * cbv[e];
                        res[e] = gelu_tanh(ua) * ub; }
                    const int row = row0 + ai * HALF + m * 16;
                    u32x2 w; w.x = cvt_pk_bf16(res[0], res[1]); w.y = cvt_pk_bf16(res[2], res[3]);
                    *(u32x2*)(act + (size_t)row * FF + col) = w;
                    asm volatile("" ::: "memory"); } } }
    }
};
}

namespace att {
#define KSWZ(row, colB) ((row) * 256 + ((colB) ^ (((row) & 7) << 4)))
#define SBAR() __builtin_amdgcn_sched_barrier(0)
constexpr int SHM_V = 64 * 64 * 2, SHM_K = 64 * 256;
constexpr float THR = 8.f;
__device__ __forceinline__ int crow(int r, int hi) { return (r & 3) + 8 * (r >> 2) + 4 * hi; }
typedef __bf16 bf16x2_t __attribute__((ext_vector_type(2)));
__device__ __forceinline__ unsigned cvtpk(float lo, float hi) { const f32x2 v = {lo, hi}; return __builtin_bit_cast(unsigned, __builtin_convertvector(v, bf16x2_t)); }
__device__ __forceinline__ void partialSM(f32x16& p0, f32x16& p1, float& m_reg, float& alpha) {
    float pmax = p0[0];
#pragma unroll
    for (int r = 1; r < 16; ++r) pmax = fmaxf(pmax, p0[r]);
#pragma unroll
    for (int r = 0; r < 16; ++r) pmax = fmaxf(pmax, p1[r]);
    { auto rr = __builtin_amdgcn_permlane32_swap(__float_as_uint(pmax), __float_as_uint(pmax), false, false);
      pmax = fmaxf(__uint_as_float(rr[0]), __uint_as_float(rr[1])); }
    float mn;
    if (__builtin_expect(__all(pmax - m_reg <= THR), 1)) { mn = m_reg; alpha = 1.f; }
    else { mn = fmaxf(m_reg, pmax); alpha = __builtin_amdgcn_exp2f(m_reg - mn); m_reg = mn; }
#pragma unroll
    for (int r = 0; r < 16; ++r) p0[r] = p0[r] - mn;
#pragma unroll
    for (int r = 0; r < 16; ++r) p1[r] = p1[r] - mn;
#pragma unroll
    for (int r = 0; r < 16; ++r) p0[r] = __builtin_amdgcn_exp2f(p0[r]);
}
__device__ __forceinline__ void finishSM(f32x16& p0, f32x16& p1, float alpha, float& l_reg, bf16x8& pa0, bf16x8& pa1, bf16x8& pa2, bf16x8& pa3) {
#pragma unroll
    for (int r = 0; r < 16; ++r) p1[r] = __builtin_amdgcn_exp2f(p1[r]);
    float ps = 0;
#pragma unroll
    for (int r = 0; r < 16; ++r) ps += p0[r];
#pragma unroll
    for (int r = 0; r < 16; ++r) ps += p1[r];
    { auto rr = __builtin_amdgcn_permlane32_swap(__float_as_uint(ps), __float_as_uint(ps), false, false);
      ps = __uint_as_float(rr[0]) + __uint_as_float(rr[1]); }
    l_reg = l_reg * alpha + ps;
#define PK4(P, BASE, OUT) do { unsigned a0 = cvtpk(P[BASE + 0], P[BASE + 1]), a1 = cvtpk(P[BASE + 2], P[BASE + 3]);   \
    unsigned b0 = cvtpk(P[BASE + 4], P[BASE + 5]), b1 = cvtpk(P[BASE + 6], P[BASE + 7]);                              \
    auto r0 = __builtin_amdgcn_permlane32_swap(a0, b0, false, false); auto r1 = __builtin_amdgcn_permlane32_swap(a1, b1, false, false); \
    u32x4 w = {r0[0], r1[0], r0[1], r1[1]}; OUT = __builtin_bit_cast(bf16x8, w); } while (0)
    PK4(p0, 0, pa0); PK4(p0, 8, pa1); PK4(p1, 0, pa2); PK4(p1, 8, pa3);
#undef PK4
}
__device__ __forceinline__ void qkt(f32x16& p0, f32x16& p1, const char* Ks, const bf16x8* qr, int r32, int hi, int tile, int kv_limit) {
    p0 = f32x16{}; p1 = f32x16{};
#pragma unroll
    for (int d0 = 0; d0 < 6; ++d0) { const int cb = (d0 * 16 + hi * 8) * 2;
        const bf16x8 b0 = *reinterpret_cast<const bf16x8*>(Ks + KSWZ(r32, cb));
        const bf16x8 b1 = *reinterpret_cast<const bf16x8*>(Ks + KSWZ(32 + r32, cb));
        p0 = __builtin_amdgcn_mfma_f32_32x32x16_bf16(b0, qr[d0], p0, 0, 0, 0);
        p1 = __builtin_amdgcn_mfma_f32_32x32x16_bf16(b1, qr[d0], p1, 0, 0, 0); }
}
__device__ __forceinline__ void qkt_n(f32x16& p0, f32x16& p1, const char* Ks, const bf16x8* qr, int r32, int hi, const f32x16& negm) {
#pragma unroll
    for (int d0 = 0; d0 < 6; ++d0) { const int cb = (d0 * 16 + hi * 8) * 2;
        const bf16x8 b0 = *reinterpret_cast<const bf16x8*>(Ks + KSWZ(r32, cb));
        const bf16x8 b1 = *reinterpret_cast<const bf16x8*>(Ks + KSWZ(32 + r32, cb));
        if (d0 == 0) { p0 = __builtin_amdgcn_mfma_f32_32x32x16_bf16(b0, qr[0], negm, 0, 0, 0); p1 = __builtin_amdgcn_mfma_f32_32x32x16_bf16(b1, qr[0], negm, 0, 0, 0); }
        else { p0 = __builtin_amdgcn_mfma_f32_32x32x16_bf16(b0, qr[d0], p0, 0, 0, 0); p1 = __builtin_amdgcn_mfma_f32_32x32x16_bf16(b1, qr[d0], p1, 0, 0, 0); } }
}
__device__ __forceinline__ void partialSMn(f32x16& p0, f32x16& p1, float& m_reg, float& alpha, f32x16& negm) {
    float pmax = p0[0];
#pragma unroll
    for (int r = 1; r < 16; ++r) pmax = fmaxf(pmax, p0[r]);
#pragma unroll
    for (int r = 0; r < 16; ++r) pmax = fmaxf(pmax, p1[r]);
    { auto rr = __builtin_amdgcn_permlane32_swap(__float_as_uint(pmax), __float_as_uint(pmax), false, false);
      pmax = fmaxf(__uint_as_float(rr[0]), __uint_as_float(rr[1])); }
    if (__builtin_expect(__all(pmax <= THR), 1)) { alpha = 1.f; }
    else { const float dl = fmaxf(pmax, 0.f); alpha = __builtin_amdgcn_exp2f(-dl); m_reg += dl;
#pragma unroll
        for (int r = 0; r < 16; ++r) { p0[r] -= dl; p1[r] -= dl; }
#pragma unroll
        for (int r = 0; r < 16; ++r) negm[r] = -m_reg; }
#pragma unroll
    for (int r = 0; r < 16; ++r) p0[r] = __builtin_amdgcn_exp2f(p0[r]);
}
__device__ __forceinline__ void kmask(f32x16& p0, f32x16& p1, int hi, int tile, int kv_limit) {
    if (64 * (tile + 1) > kv_limit) {
        const int base = 64 * tile + 4 * hi;
#pragma unroll
        for (int r = 0; r < 16; ++r) { const int kv = base + (r & 3) + 8 * (r >> 2); if (kv >= kv_limit) p0[r] = -1e30f; if (kv + 32 >= kv_limit) p1[r] = -1e30f; }
    }
}
__device__ __forceinline__ int v_st(int k, int c) { const int kk = (k & ~0xC) | ((k & 4) << 1) | ((k & 8) >> 1); return ((kk >> 3) * 2 + (c >> 5)) * 512 + ((kk & 7) * 32 + (c & 31)) * 2; }
__device__ __forceinline__ int v_rd_base(int lane) { return ((lane & 3) << 3) | (((lane >> 2) & 3) << 6) | (((lane >> 4) & 1) << 5) | (((lane >> 5) & 1) << 8); }
constexpr int v_rd_off(int d0, int ks, int half) { return d0 * 512 + ks * 2048 + half * 1024; }
template <int OFF> __device__ __forceinline__ s16x4 tr_read(int vb) {
    s16x4 r; asm volatile("ds_read_b64_tr_b16 %0, %1 offset:%2" : "=&v"(r) : "v"(vb), "i"(OFF) : "memory"); return r;
}
template <int D0> __device__ __forceinline__ void pv_one(f32x16& od, int vb, bf16x8 pa0, bf16x8 pa1, bf16x8 pa2, bf16x8 pa3) {
    const s16x4 l0 = tr_read<v_rd_off(D0, 0, 0)>(vb), h0 = tr_read<v_rd_off(D0, 0, 1)>(vb), l1 = tr_read<v_rd_off(D0, 1, 0)>(vb), h1 = tr_read<v_rd_off(D0, 1, 1)>(vb);
    const s16x4 l2 = tr_read<v_rd_off(D0, 2, 0)>(vb), h2 = tr_read<v_rd_off(D0, 2, 1)>(vb), l3 = tr_read<v_rd_off(D0, 3, 0)>(vb), h3 = tr_read<v_rd_off(D0, 3, 1)>(vb);
    asm volatile("s_waitcnt lgkmcnt(0)" ::: "memory"); SBAR();
#define PK(L, H) (bf16x8){L[0], L[1], L[2], L[3], H[0], H[1], H[2], H[3]}
    od = __builtin_amdgcn_mfma_f32_32x32x16_bf16(pa0, PK(l0, h0), od, 0, 0, 0);
    od = __builtin_amdgcn_mfma_f32_32x32x16_bf16(pa1, PK(l1, h1), od, 0, 0, 0);
    od = __builtin_amdgcn_mfma_f32_32x32x16_bf16(pa2, PK(l2, h2), od, 0, 0, 0);
    od = __builtin_amdgcn_mfma_f32_32x32x16_bf16(pa3, PK(l3, h3), od, 0, 0, 0);
#undef PK
}
__device__ __forceinline__ void pv_d0(f32x16* o, int vb, bf16x8 pa0, bf16x8 pa1, bf16x8 pa2, bf16x8 pa3) {
    pv_one<0>(o[0], vb, pa0, pa1, pa2, pa3); pv_one<1>(o[1], vb, pa0, pa1, pa2, pa3);
}
template <bool ALLACT> __device__ __forceinline__ void attn_unit(const bf16_t* __restrict__ Qb, const bf16_t* __restrict__ Kn, const bf16_t* __restrict__ Kr, const bf16_t* __restrict__ Vh,
                                          bf16_t* __restrict__ Ob, int NT, int kv_limit, bool active_, int nq_valid, char* lds) {
    const bool active = ALLACT ? true : active_;
    int tid = threadIdx.x; asm volatile("" : "+v"(tid));
    const int wid = tid >> 6, lane = tid & 63, r32 = lane & 31, hi = lane >> 5;
    char* V_lds = lds; char* K_lds = lds + 3 * SHM_V;
    float* ws = (float*)(lds + 3 * SHM_V + 3 * SHM_K) + wid * 64; float* li_l = ws; float* al_l = ws + 32;
    float m_reg = -1e30f, l_reg = 0; f32x16 o[2] = {}; bf16x8 qr[6];
    const bf16_t* Qw = Qb + (size_t)(wid * 32 + r32) * NQ + hi * 8;
#pragma unroll
    for (int d0 = 0; d0 < 6; ++d0) qr[d0] = *reinterpret_cast<const bf16x8*>(Qw + d0 * 16);
    const int kr0 = tid / 12, kc0 = tid % 12, kr1 = (512 + (tid >> 1)) / 12, kc1 = (512 + (tid >> 1)) % 12, kh1 = tid & 1, vr = tid >> 3, vc = tid & 7;
    const bf16_t* kp0 = (kc0 < 8) ? Kn + (size_t)kr0 * 1024 + kc0 * 8 : Kr + (size_t)kr0 * 32 + (kc0 - 8) * 8; const size_t ks0 = (kc0 < 8) ? 64 * 1024 : 64 * 32;
    const bf16_t* kp1 = ((kc1 < 8) ? Kn + (size_t)kr1 * 1024 + kc1 * 8 : Kr + (size_t)kr1 * 32 + (kc1 - 8) * 8) + kh1 * 4; const size_t ks1 = (kc1 < 8) ? 64 * 1024 : 64 * 32;
    const bf16_t* vp = Vh + (size_t)vr * 1024 + vc * 8;
    const int kst0 = KSWZ(kr0, kc0 * 16), kst1 = KSWZ(kr1, kc1 * 16) + kh1 * 8, vst = v_st(vr, vc * 8);
    const int vb0 = (int)(uintptr_t)V_lds + v_rd_base(lane);
    struct { bf16x8 k0; s16x4 k1; bf16x8 v; } sr_[2];
#define SLOAD(i, t) do { sr_[i].k0 = *reinterpret_cast<const bf16x8*>(kp0 + (size_t)(t) * ks0); sr_[i].k1 = *reinterpret_cast<const s16x4*>(kp1 + (size_t)(t) * ks1); \
    sr_[i].v = *reinterpret_cast<const bf16x8*>(vp + (size_t)(t) * 65536); } while (0)
#define SWRITE(b, i) do { *(bf16x8*)(K_lds + (b) * SHM_K + kst0) = sr_[i].k0; *(s16x4*)(K_lds + (b) * SHM_K + kst1) = sr_[i].k1; \
    *(bf16x8*)(V_lds + (b) * SHM_V + vst) = sr_[i].v; } while (0)
#define RESC(a) do { if (active) { if (__any((a) < 1.f)) { if (hi == 0) al_l[r32] = (a); asm volatile("s_waitcnt lgkmcnt(0)" ::: "memory"); \
    _Pragma("unroll") for (int d = 0; d < 2; ++d) _Pragma("unroll") for (int r = 0; r < 16; ++r) o[d][r] *= al_l[crow(r, hi)]; } } } while (0)
    f32x16 pA0 = {}, pA1 = {}, pB0 = {}, pB1 = {}; float alA = 1.f, alB = 1.f; bf16x8 pa0, pa1, pa2, pa3;
    SLOAD(0, 0); SWRITE(0, 0); SLOAD(1, 1); if (2 < NT) SLOAD(0, 2);
    __syncthreads();
    if (active) { qkt(pA0, pA1, K_lds, qr, r32, hi, 0, kv_limit); kmask(pA0, pA1, hi, 0, kv_limit); partialSM(pA0, pA1, m_reg, alA); }
    f32x16 negm;
#pragma unroll
    for (int r = 0; r < 16; ++r) negm[r] = -m_reg;
    SWRITE(1, 1); if (3 < NT) SLOAD(1, 3);
    __syncthreads();
    int sp = 0, sc = 1, sn = 2;
    for (int j = 1; j + 1 < NT; j += 2) {
        if (active) { SBAR(); qkt_n(pB0, pB1, K_lds + sc * SHM_K, qr, r32, hi, negm);
            finishSM(pA0, pA1, alA, l_reg, pa0, pa1, pa2, pa3); SBAR(); }
        SWRITE(sn, 0); if (j + 3 < NT) SLOAD(0, j + 3);
        SBAR();
        if (active) { kmask(pB0, pB1, hi, j, kv_limit); SBAR(); pv_d0(o, vb0 + sp * SHM_V, pa0, pa1, pa2, pa3); partialSMn(pB0, pB1, m_reg, alB, negm); }
        RESC(alB); __syncthreads();
        { const int t_ = sp; sp = sc; sc = sn; sn = t_; }
        if (active) { SBAR(); qkt_n(pA0, pA1, K_lds + sc * SHM_K, qr, r32, hi, negm);
            finishSM(pB0, pB1, alB, l_reg, pa0, pa1, pa2, pa3); SBAR(); }
        if (j + 2 < NT) { SWRITE(sn, 1); if (j + 4 < NT) SLOAD(1, j + 4); }
        SBAR();
        if (active) { kmask(pA0, pA1, hi, j + 1, kv_limit); SBAR(); pv_d0(o, vb0 + sp * SHM_V, pa0, pa1, pa2, pa3); partialSMn(pA0, pA1, m_reg, alA, negm); }
        RESC(alA); __syncthreads();
        { const int t_ = sp; sp = sc; sc = sn; sn = t_; }
    }
    if (active) {
        SBAR(); qkt_n(pB0, pB1, K_lds + sc * SHM_K, qr, r32, hi, negm);
        finishSM(pA0, pA1, alA, l_reg, pa0, pa1, pa2, pa3); SBAR();
        kmask(pB0, pB1, hi, NT - 1, kv_limit); SBAR();
        pv_d0(o, vb0 + sp * SHM_V, pa0, pa1, pa2, pa3); partialSMn(pB0, pB1, m_reg, alB, negm);
    }
    RESC(alB);
    if (active) {
        finishSM(pB0, pB1, alB, l_reg, pa0, pa1, pa2, pa3); SBAR();
        pv_d0(o, vb0 + sc * SHM_V, pa0, pa1, pa2, pa3);
        if (hi == 0) li_l[r32] = l_reg; asm volatile("s_waitcnt lgkmcnt(0)" ::: "memory");
        float rli[16];
#pragma unroll
        for (int r = 0; r < 16; ++r) rli[r] = __builtin_amdgcn_rcpf(li_l[crow(r, hi)]);
        bf16_t* Ow = Ob + (size_t)(wid * 32) * 1024;
#pragma unroll
        for (int r = 0; r < 16; ++r) { const int orow = crow(r, hi);
            if (wid * 32 + orow < nq_valid) {
#pragma unroll
                for (int d0 = 0; d0 < 2; ++d0) Ow[(size_t)orow * 1024 + d0 * 32 + r32] = (bf16_t)f2bf(o[d0][r] * rli[r]); } }
    }
    __syncthreads();
#undef SLOAD
#undef SWRITE
#undef RESC
}

__device__ __forceinline__ int v_st8(int k, int c) { const int kk = (k & ~0xC) | ((k & 4) << 1) | ((k & 8) >> 1); return ((kk >> 3) * 8 + (c >> 5)) * 512 + ((kk & 7) * 32 + (c & 31)) * 2; }
#define KSWZ5(row, colB) ((row) * 512 + ((colB) ^ (((row) & 7) << 4)))
constexpr int SL_QL = 0, SL_KL = 0, SL_KR = 32768, SL_V = 36864, SL_WS = 73728;
template <int D0> __device__ __forceinline__ void pv8_one(f32x16& od, int vb, bf16x8 pa0, bf16x8 pa1, bf16x8 pa2, bf16x8 pa3) {
    const s16x4 l0 = tr_read<D0 * 512 + 0 * 8192>(vb), h0 = tr_read<D0 * 512 + 0 * 8192 + 4096>(vb), l1 = tr_read<D0 * 512 + 1 * 8192>(vb), h1 = tr_read<D0 * 512 + 1 * 8192 + 4096>(vb);
    const s16x4 l2 = tr_read<D0 * 512 + 2 * 8192>(vb), h2 = tr_read<D0 * 512 + 2 * 8192 + 4096>(vb), l3 = tr_read<D0 * 512 + 3 * 8192>(vb), h3 = tr_read<D0 * 512 + 3 * 8192 + 4096>(vb);
    asm volatile("s_waitcnt lgkmcnt(0)" ::: "memory"); SBAR();
#define PK(L, H) (bf16x8){L[0], L[1], L[2], L[3], H[0], H[1], H[2], H[3]}
    od = __builtin_amdgcn_mfma_f32_32x32x16_bf16(pa0, PK(l0, h0), od, 0, 0, 0);
    od = __builtin_amdgcn_mfma_f32_32x32x16_bf16(pa1, PK(l1, h1), od, 0, 0, 0);
    od = __builtin_amdgcn_mfma_f32_32x32x16_bf16(pa2, PK(l2, h2), od, 0, 0, 0);
    od = __builtin_amdgcn_mfma_f32_32x32x16_bf16(pa3, PK(l3, h3), od, 0, 0, 0);
#undef PK
}
__device__ __forceinline__ bf16x8 cvt8(f32x4 a, f32x4 b) { u32x4 w = {cvtpk(a[0], a[1]), cvtpk(a[2], a[3]), cvtpk(b[0], b[1]), cvtpk(b[2], b[3])}; return __builtin_bit_cast(bf16x8, w); }
__device__ __forceinline__ void sample_unit(int b, int s, const bf16_t* __restrict__ Q, const float* __restrict__ w_uk, const float* __restrict__ cckv, const float* __restrict__ ckr,
                                            const bf16_t* __restrict__ ckvn, const bf16_t* __restrict__ kr, float* __restrict__ PO, float* __restrict__ PM, float* __restrict__ PL, char* lds) {
    int tid = threadIdx.x; asm volatile("" : "+v"(tid));
    const int wid = __builtin_amdgcn_readfirstlane(tid >> 6), lane = tid & 63, r32 = lane & 31, hi = lane >> 5;
    const int rbq = wid & 3, vh = wid >> 2;
    {
        const int h = wid;
        const bf16_t* qrow = Q + ((size_t)MP + (size_t)b * DS + (r32 & 15)) * NQ + h * 96;
        bf16x8 aq[4];
#pragma unroll
        for (int ks = 0; ks < 4; ++ks) { aq[ks] = *reinterpret_cast<const bf16x8*>(qrow + ks * 16 + hi * 8); if (r32 >= 16) aq[ks] = bf16x8{}; }
#pragma unroll 2
        for (int rb = 0; rb < 8; ++rb) {
            f32x16 acc = {};
            const float* wp = w_uk + ((size_t)(rb * 32 + r32) * 8 + h) * 64 + hi * 8;
#pragma unroll
            for (int ks = 0; ks < 4; ++ks) { const f32x4 w0 = *(const f32x4*)(wp + ks * 16), w1 = *(const f32x4*)(wp + ks * 16 + 4);
                acc = __builtin_amdgcn_mfma_f32_32x32x16_bf16(aq[ks], cvt8(w0, w1), acc, 0, 0, 0); }
#pragma unroll
            for (int i = 0; i < 8; ++i) { const int t = (i & 3) + 8 * (i >> 2) + 4 * hi;
                *(bf16_t*)(lds + SL_QL + (size_t)(h * 16 + t) * 576 + (rb * 32 + r32) * 2) = (bf16_t)f2bf(acc[i]); }
        }
        { const int t = lane >> 2, j8 = (lane & 3) * 8;
          const bf16x8 rp = *reinterpret_cast<const bf16x8*>(Q + ((size_t)MP + (size_t)b * DS + t) * NQ + h * 96 + 64 + j8);
          *(bf16x8*)(lds + SL_QL + (size_t)(h * 16 + t) * 576 + (256 + j8) * 2) = rp; }
    }
    __syncthreads();
    bf16x8 qr[18];
#pragma unroll
    for (int d0 = 0; d0 < 18; ++d0) qr[d0] = *reinterpret_cast<const bf16x8*>(lds + SL_QL + (size_t)(rbq * 32 + r32) * 576 + (d0 * 16 + hi * 8) * 2);
    __syncthreads();
    char* Kl = lds + SL_KL; char* Kr = lds + SL_KR; char* Vl = lds + SL_V;
    float* wsl = (float*)(lds + SL_WS) + wid * 64; float* al_l = wsl;
    const int vb = (int)(uintptr_t)Vl + v_rd_base(lane) + vh * 4 * 512;
    float m_reg = -1e30f, l_reg = 0.f; f32x16 o[4] = {};
    const int ntile = (s == 7) ? 5 : 4;
    for (int j = 0; j < ntile; ++j) {
        const int kb = (j < 4) ? s * 256 + j * 64 : PAST;
        bf16x8 kc[4], rc = bf16x8{};
        if (kb < PAST) {
#pragma unroll
            for (int q = 0; q < 4; ++q) { const int c = tid + 512 * q, key = c >> 5, ch = c & 31;
                const float* src = cckv + ((size_t)b * PAST + kb + key) * KVL + ch * 8;
                kc[q] = cvt8(__builtin_nontemporal_load((const f32x4*)src), __builtin_nontemporal_load((const f32x4*)(src + 4))); }
            if (tid < 256) { const int key = tid >> 2, ch = tid & 3; const float* src = ckr + ((size_t)b * PAST + kb + key) * ROPE + ch * 8;
                rc = cvt8(__builtin_nontemporal_load((const f32x4*)src), __builtin_nontemporal_load((const f32x4*)(src + 4))); }
        } else {
#pragma unroll
            for (int q = 0; q < 4; ++q) { const int c = tid + 512 * q, key = c >> 5, ch = c & 31;
                kc[q] = (key < DS) ? *reinterpret_cast<const bf16x8*>(ckvn + ((size_t)MP + (size_t)b * DS + key) * KVL + ch * 8) : bf16x8{}; }
            if (tid < 256) { const int key = tid >> 2, ch = tid & 3;
                rc = (key < DS) ? *reinterpret_cast<const bf16x8*>(kr + ((size_t)MP + (size_t)b * DS + key) * ROPE + ch * 8) : bf16x8{}; }
        }
        __syncthreads();
#pragma unroll
        for (int q = 0; q < 4; ++q) { const int c = tid + 512 * q, key = c >> 5, ch = c & 31;
            *(bf16x8*)(Kl + KSWZ5(key, ch * 16)) = kc[q]; *(bf16x8*)(Vl + v_st8(key, ch * 8)) = kc[q]; }
        if (tid < 256) { const int key = tid >> 2, ch = tid & 3; *(bf16x8*)(Kr + key * 64 + ch * 16) = rc; }
        __syncthreads();
        f32x16 p0 = {}, p1 = {};
#pragma unroll
        for (int d0 = 0; d0 < 16; ++d0) { const int cb = (d0 * 16 + hi * 8) * 2;
            const bf16x8 b0 = *reinterpret_cast<const bf16x8*>(Kl + KSWZ5(r32, cb));
            const bf16x8 b1 = *reinterpret_cast<const bf16x8*>(Kl + KSWZ5(32 + r32, cb));
            p0 = __builtin_amdgcn_mfma_f32_32x32x16_bf16(b0, qr[d0], p0, 0, 0, 0);
            p1 = __builtin_amdgcn_mfma_f32_32x32x16_bf16(b1, qr[d0], p1, 0, 0, 0); }
#pragma unroll
        for (int d0 = 0; d0 < 2; ++d0) { const int cb = (d0 * 16 + hi * 8) * 2;
            const bf16x8 b0 = *reinterpret_cast<const bf16x8*>(Kr + r32 * 64 + cb);
            const bf16x8 b1 = *reinterpret_cast<const bf16x8*>(Kr + (32 + r32) * 64 + cb);
            p0 = __builtin_amdgcn_mfma_f32_32x32x16_bf16(b0, qr[16 + d0], p0, 0, 0, 0);
            p1 = __builtin_amdgcn_mfma_f32_32x32x16_bf16(b1, qr[16 + d0], p1, 0, 0, 0); }
        if (kb + 64 > PAST + DS) {
#pragma unroll
            for (int r = 0; r < 16; ++r) { const int kv = kb + 4 * hi + (r & 3) + 8 * (r >> 2); if (kv >= PAST + DS) p0[r] = -1e30f; if (kv + 32 >= PAST + DS) p1[r] = -1e30f; }
        }
        float alpha; bf16x8 pa0, pa1, pa2, pa3;
        partialSM(p0, p1, m_reg, alpha);
        finishSM(p0, p1, alpha, l_reg, pa0, pa1, pa2, pa3);
        if (__any(alpha < 1.f)) { if (hi == 0) al_l[r32] = alpha; asm volatile("s_waitcnt lgkmcnt(0)" ::: "memory");
#pragma unroll
            for (int d = 0; d < 4; ++d)
#pragma unroll
                for (int r = 0; r < 16; ++r) o[d][r] *= al_l[crow(r, hi)]; }
        SBAR();
        pv8_one<0>(o[0], vb, pa0, pa1, pa2, pa3); pv8_one<1>(o[1], vb, pa0, pa1, pa2, pa3); pv8_one<2>(o[2], vb, pa0, pa1, pa2, pa3); pv8_one<3>(o[3], vb, pa0, pa1, pa2, pa3);
    }
    const size_t pbase = ((size_t)b * 8 + s) * 128 + rbq * 32;
    if (vh == 0 && hi == 0) { PM[pbase + r32] = m_reg; PL[pbase + r32] = l_reg; }
#pragma unroll
    for (int r = 0; r < 16; ++r) { float* op = PO + (pbase + crow(r, hi)) * 256 + vh * 128 + r32;
#pragma unroll
        for (int d0 = 0; d0 < 4; ++d0) op[d0 * 32] = o[d0][r]; }
    __syncthreads();
}
#undef SBAR
}

struct Args { const float* in[28]; float* out; unsigned char* ws; };

__device__ __forceinline__ void transpose_item(const float* __restrict__ W, int ldw, const float* __restrict__ gk, bf16_t* WT, int K, int n_dst0, int n_src0, int k0, LAS float* scr, int lane) {
    float tv[32];
#pragma unroll
    for (int i = 0; i < 32; ++i) { const int kk = 2 * i + (lane >> 5); tv[i] = __builtin_nontemporal_load(&W[(size_t)(k0 + kk) * ldw + n_src0 + (lane & 31)]); }
#pragma unroll
    for (int i = 0; i < 32; ++i) { const int kk = 2 * i + (lane >> 5); float v = tv[i]; if (gk) v *= gk[k0 + kk]; scr[kk * 33 + (lane & 31)] = v; }
    asm volatile("s_waitcnt lgkmcnt(0)" ::: "memory");
    const int c = lane & 7;
#pragma unroll
    for (int j = 0; j < 4; ++j) { const int n = (lane >> 3) + 8 * j; const LAS float* s = scr + (8 * c) * 33 + n;
        u32x4 o; o.x = pk2(s[0 * 33], s[1 * 33]); o.y = pk2(s[2 * 33], s[3 * 33]); o.z = pk2(s[4 * 33], s[5 * 33]); o.w = pk2(s[6 * 33], s[7 * 33]);
        *(u32x4*)(WT + (size_t)(n_dst0 + n) * K + k0 + 8 * c) = o; }
    asm volatile("s_waitcnt lgkmcnt(0)" ::: "memory");
}


#define XB_TMO      128
#define XB_XCNT(j)  (256  + 64 * (j))
#define XB_XSUB(j)  (1280 + 64 * (j))
#define XB_XGEN(j)  (2304 + 64 * (j))
#define XB_TOP      3328
#define XB_TOPGEN   3392
#define XCD_BAR_WORDS 3456
#define XB_SPIN_CAP (1u << 22)
__device__ __forceinline__ unsigned xb_ld(unsigned* p)              { return __hip_atomic_load(p, __ATOMIC_RELAXED, __HIP_MEMORY_SCOPE_AGENT); }
__device__ __forceinline__ unsigned xb_add(unsigned* p, unsigned v) { return __hip_atomic_fetch_add(p, v, __ATOMIC_RELAXED, __HIP_MEMORY_SCOPE_AGENT); }
__device__ __forceinline__ unsigned xb_xcc_id() { return (unsigned)__builtin_amdgcn_s_getreg((3 << 11) | 20) & 0xFu; }
#define XB_SPIN(cond, bar) do { unsigned _sp = 0; while (cond) { __builtin_amdgcn_s_sleep(1); \
    if ((++_sp & 255u) == 0u) { if (xb_ld(&(bar)[XB_TMO])) break; if (_sp > XB_SPIN_CAP) { atomicAdd(&(bar)[XB_TMO], 1u); break; } } } } while (0)
struct XcdBarrier { unsigned* bar; unsigned x; volatile LAS unsigned* st; };
__device__ __forceinline__ XcdBarrier xcd_barrier_post(unsigned* bar, volatile LAS unsigned* st) {
    XcdBarrier b; b.bar = bar; b.x = xb_xcc_id(); b.st = st;
    if (threadIdx.x == 0) (void)xb_add(&bar[XB_XCNT(b.x)], 1u);
    return b;
}
__device__ __forceinline__ void xcd_barrier_complete(unsigned* bar, unsigned x, unsigned& nloc, unsigned& nx) {
    const unsigned G = gridDim.x * gridDim.y * gridDim.z;
    unsigned sum, cnt, mine, sp = 0u;
    for (;;) {
        sum = 0u; cnt = 0u; mine = 0u;
#pragma unroll
        for (unsigned j = 0; j < 16; ++j) { const unsigned c = xb_ld(&bar[XB_XCNT(j)]); sum += c; cnt += (c > 0u) ? 1u : 0u; mine = (j == x) ? c : mine; }
        if (sum == G) break;
        __builtin_amdgcn_s_sleep(1);
        if ((++sp & 255u) == 0u) { if (xb_ld(&bar[XB_TMO])) break; if (sp > XB_SPIN_CAP) { atomicAdd(&bar[XB_TMO], 1u); break; } }
    }
    nloc = mine > 0u ? mine : 1u; nx = cnt > 0u ? cnt : 1u;
}
__device__ __forceinline__ void xcd_barrier(const XcdBarrier& b) {
    asm volatile("s_waitcnt vmcnt(0)" ::: "memory");
    __syncthreads();
    if (threadIdx.x == 0) {
        unsigned* bar = b.bar;
        __builtin_amdgcn_s_waitcnt(0);
        unsigned nloc = b.st[0], nx = b.st[1];
        if (nloc == 0u) { xcd_barrier_complete(bar, b.x, nloc, nx); b.st[0] = nloc; b.st[1] = nx; }
        const unsigned old = xb_add(&bar[XB_XSUB(b.x)], 1u);
        const unsigned gen = old / nloc;
        if (old + 1u == (gen + 1u) * nloc) {
            __builtin_amdgcn_fence(__ATOMIC_RELEASE, "agent");
            asm volatile("s_waitcnt vmcnt(0)" ::: "memory");
            const unsigned og = xb_add(&bar[XB_TOP], 1u);
            const unsigned tg = og / nx;
            if (og + 1u == (tg + 1u) * nx) xb_add(&bar[XB_TOPGEN], 1u);
            else XB_SPIN(xb_ld(&bar[XB_TOPGEN]) == tg, bar);
            __builtin_amdgcn_fence(__ATOMIC_ACQUIRE, "agent");
            xb_add(&bar[XB_XGEN(b.x)], 1u);
            asm volatile("s_waitcnt vmcnt(0)" ::: "memory");
        } else {
            XB_SPIN(xb_ld(&bar[XB_XGEN(b.x)]) == gen, bar);
            __builtin_amdgcn_fence(__ATOMIC_ACQUIRE, "agent");
            asm volatile("s_waitcnt vmcnt(0)" ::: "memory");
        }
    }
    __syncthreads();
}
#define CAS __attribute__((address_space(4)))
__device__ __forceinline__ const float* karg_f(int k) { return ((const float* const CAS*)__builtin_amdgcn_kernarg_segment_ptr())[k]; }
__device__ __forceinline__ unsigned char* karg_ws() { return ((unsigned char* const CAS*)__builtin_amdgcn_kernarg_segment_ptr())[29]; }
__device__ __forceinline__ float* karg_out() { return ((float* const CAS*)__builtin_amdgcn_kernarg_segment_ptr())[28]; }
__global__ void __launch_bounds__(512, 2) fwd_megakernel(Args a) {
    extern __shared__ __attribute__((aligned(16))) unsigned char lds[];
    cg::grid_group grid = cg::this_grid();
    LAS unsigned char* ldsl = (LAS unsigned char*)lds;
    const int G = gridDim.x, bx = blockIdx.x;
    volatile LAS unsigned* MISC = (volatile LAS unsigned*)(ldsl + LDS_HALO + 8192);
    if (threadIdx.x < 8) MISC[threadIdx.x] = 0u;
    __syncthreads();
    XcdBarrier xbar = xcd_barrier_post((unsigned*)(karg_ws() + WS_BAR), MISC);
#define GRID_BAR() xcd_barrier(xbar)
#define PHASE_IDS() int tid = threadIdx.x; asm volatile("" : "+v"(tid)); const int lane = tid & 63, wave = __builtin_amdgcn_readfirstlane(tid >> 6); \
    const int vcu = (G % 8 == 0) ? (bx % 8) * (G / 8) + bx / 8 : bx; const int gw = vcu * 8 + wave, NGW = G * 8; \
    const unsigned gt = (unsigned)bx * 512u + (unsigned)tid, NGT = (unsigned)G * 512u; (void)lane; (void)gw; (void)NGW; (void)gt; (void)NGT; (void)vcu;
#define x_prompt (karg_f(0))
#define x_sample (karg_f(1))
#define cache_ckv (karg_f(2))
#define cache_krope (karg_f(3))
#define state_rg_h (karg_f(4))
#define state_rg_conv (karg_f(5))
#define state_ffn_conv (karg_f(6))
#define norm_mix_g (karg_f(7))
#define w_in (karg_f(8))
#define q_norm_g (karg_f(9))
#define w_uq (karg_f(10))
#define kv_norm_g (karg_f(11))
#define w_uk (karg_f(12))
#define w_uv (karg_f(13))
#define w_rg_conv (karg_f(14))
#define b_rg_conv (karg_f(15))
#define w_rg_a (karg_f(16))
#define b_rg_a (karg_f(17))
#define w_rg_i (karg_f(18))
#define b_rg_i (karg_f(19))
#define rg_lambda (karg_f(20))
#define w_out (karg_f(21))
#define norm_ffn_g (karg_f(22))
#define w_ffn_up (karg_f(23))
#define w_ffn_conv (karg_f(24))
#define b_ffn_conv (karg_f(25))
#define w_ffn_down (karg_f(26))
#define final_norm_g (karg_f(27))
#define ws (karg_ws())
#define out (karg_out())
#define SP ((float*)(ws + WS_SP))
#define SA ((float*)(ws + WS_SA))
#define SU ((float*)(ws + WS_SU))
#define ROPE_T ((f32x2*)(ws + WS_ROPE))
#define SSQ2 ((float*)(ws + WS_SSQ2))
#define SSQ3 ((float*)(ws + WS_SSQ3))
#define WIN ((bf16_t*)(ws + WS_WIN))
#define WUQ ((bf16_t*)(ws + WS_WUQ))
#define WKV ((bf16_t*)(ws + WS_WKV))
#define WRG ((bf16_t*)(ws + WS_WRG))
#define WOUT ((bf16_t*)(ws + WS_WOUT))
#define WUP ((bf16_t*)(ws + WS_WUP))
#define WDN ((bf16_t*)(ws + WS_WDN))
#define XN ((bf16_t*)(ws + WS_XN))
#define PROJ ((bf16_t*)(ws + WS_PROJ))
#define KV ((bf16_t*)(ws + WS_KV))
#define ACT ((bf16_t*)(ws + WS_ACT))
#define CQN ((bf16_t*)(ws + WS_CQN))
#define XC ((bf16_t*)(ws + WS_XC))
#define CKVN ((bf16_t*)(ws + WS_CKVN))
#define CAT ((bf16_t*)(ws + WS_CAT))
#define HT ((float*)(ws + WS_HT))
#define UPS ((float*)(ws + WS_UPS))
#define LA ((const _Float16*)(ws + WS_LA))
#define KR ((bf16_t*)(ws + WS_KR))
#define X1B ((bf16_t*)(ws + WS_X1B))
#define Y (out + O_Y)
#define QB ((bf16_t*)((unsigned char*)out + YS_Q))
#define GG ((bf16_t*)((unsigned char*)out + YS_GG))
#define UB ((bf16_t*)((unsigned char*)out + YS_U))
#if (PHMASK >> 0) & 1
    for (int rep_ = 0; rep_ <= ((DUPMASK >> 0) & 1); ++rep_)
    {
    PHASE_IDS();
    {
        LAS float* scr = (LAS float*)(ldsl + wave * 16384);
        constexpr int I_IN = 16 * 53, I_UQ = 6 * 24, I_KV = 4 * 32, I_OUT = 16 * 32, I_UP = 16 * 176, I_DN = 44 * 32;
        constexpr int NITEMS = I_IN + I_UQ + I_KV + I_OUT + I_UP + I_DN;
        for (int it = gw; it < NITEMS; it += NGW) {
            int r = it;
            if (r < I_IN) { const int kb = r / 53, nb = r % 53, n = nb * 32; const int src = (n < 640) ? n : (n < 1664 ? n + 32 : n - 1024);
                transpose_item(w_in, 1696, norm_mix_g, WIN, 1024, n, src, kb * 64, scr, lane); continue; } r -= I_IN;
            if (r < I_UQ) { const int kb = r / 24, nb = r % 24; transpose_item(w_uq, 768, q_norm_g, WUQ, 384, nb * 32, nb * 32, kb * 64, scr, lane); continue; } r -= I_UQ;
            if (r < I_KV) { const int kb = r / 32, nb = r % 32, n = nb * 32; transpose_item(n < 512 ? w_uk : w_uv, 512, nullptr, WKV, 256, n, n & 511, kb * 64, scr, lane); continue; } r -= I_KV;
            if (r < I_OUT) { const int kb = r / 32, nb = r % 32; transpose_item(w_out, 1024, nullptr, WOUT, 1024, nb * 32, nb * 32, kb * 64, scr, lane); continue; } r -= I_OUT;
            if (r < I_UP) { const int kb = r / 176, nb = r % 176, n = nb * 32; const int src = ((n >> 7) & 1) * FF + (n >> 8) * 128 + (n & 127);
                transpose_item(w_ffn_up, FF2, norm_ffn_g, WUP, 1024, n, src, kb * 64, scr, lane); continue; } r -= I_UP;
            { const int kb = r / 32, nb = r % 32; transpose_item(w_ffn_down, 1024, nullptr, WDN, FF, nb * 32, nb * 32, kb * 64, scr, lane); }
        }
        for (unsigned i = gt; i < (size_t)96 * 1024 / 8; i += NGT) ((u32x4*)(WIN + (size_t)1696 * 1024))[i] = (u32x4){0u, 0u, 0u, 0u};
        for (unsigned i = gt; i < (size_t)1024 * 64; i += NGT) {
            const int n = (int)(i >> 6), k0 = (int)(i & 63) * 8; const int ch = (n >> 8) * 128 + (n & 127), blk = ch >> 6, d = ch & 63;
            u32x4 o = (u32x4){0u, 0u, 0u, 0u};
            if ((k0 >> 6) == blk) { const float* w = (((n >> 7) & 1) ? w_rg_i : w_rg_a) + ((size_t)blk * 64 + (k0 & 63)) * 64 + d;
                o.x = pk2(w[0], w[64]); o.y = pk2(w[128], w[192]); o.z = pk2(w[256], w[320]); o.w = pk2(w[384], w[448]); }
            *(u32x4*)(WRG + (size_t)n * 512 + k0) = o; }
        for (unsigned i = gt; i < (size_t)8192 * 16; i += NGT) {
            const int pos = (int)(i >> 4), f = (int)(i & 15);
            const float inv = exp2f(-(float)f * 0.83048202372184059f);
            const float ang = (float)pos * inv;
            const float k = rintf(ang * 0.15915494309189535f);
            float rr = fmaf(-k, 6.28125f, ang); rr = fmaf(-k, 1.9353071795864769e-3f, rr);
            ROPE_T[i] = (f32x2){__cosf(rr), __sinf(rr)}; }
        if (bx == 0) SP[tid] = log1pf(expf(-rg_lambda[tid]));
        for (int r = gw; r < MT; r += NGW) {
            const f32x4* xr = (const f32x4*)(r < MP ? x_prompt + (size_t)r * DM : x_sample + (size_t)(r - MP) * DM) + lane;
            f32x4 v[4]; float s = 0.f;
#pragma unroll
            for (int j = 0; j < 4; ++j) { v[j] = __builtin_nontemporal_load(&xr[64 * j]); s += (v[j][0] * v[j][0] + v[j][1] * v[j][1]) + (v[j][2] * v[j][2] + v[j][3] * v[j][3]); }
            const float rs = 1.0f / sqrtf(wave_sum(s) * (1.0f / DM) + EPS);
            u32x2* o8 = (u32x2*)(XN + (size_t)r * DM) + lane;
#pragma unroll
            for (int j = 0; j < 4; ++j) { u32x2 w; w.x = pk2(v[j][0] * rs, v[j][1] * rs); w.y = pk2(v[j][2] * rs, v[j][3] * rs); o8[64 * j] = w; }
        }
    }
    }
#endif
    if (gridDim.x == 0x7fffffffu) grid.sync();
    GRID_BAR();

#if (PHMASK >> 1) & 1
    for (int rep_ = 0; rep_ <= ((DUPMASK >> 1) & 1); ++rep_)
    {
    PHASE_IDS();
    {
        pg8::Gemm g{XN, WIN, 1024, 1024}; pg8::StaticOrder S; S.init(MT, NIN, 1024, G, bx);
        pg8::EpiStore<false> E{PROJ, NIN};
        pg8::gemm_phase<pg8::EpiStore<false>, pg8::StaticOrder>(ldsl, g, S, E);
    }
    }
#endif
    GRID_BAR();

#if (PHMASK >> 2) & 1
    for (int rep_ = 0; rep_ <= ((DUPMASK >> 2) & 1); ++rep_)
    {
    PHASE_IDS();
    float kvg[2][2], brg[8], wrg[4][8];
#pragma unroll
    for (int j = 0; j < 2; ++j) { kvg[j][0] = kv_norm_g[2 * (lane + 64 * j)]; kvg[j][1] = kv_norm_g[2 * (lane + 64 * j) + 1]; }
#pragma unroll
    for (int e = 0; e < 8; ++e) { brg[e] = b_rg_conv[lane * 8 + e];
#pragma unroll
        for (int k = 0; k < 4; ++k) wrg[k][e] = w_rg_conv[k * RGW + lane * 8 + e]; }
    for (int r = gw; r < MT; r += NGW) {
        const bf16_t* pr = PROJ + (size_t)r * NIN;
        const bool isp = r < MP; const int rb = isp ? (r >> 13) : ((r - MP) >> 4), t = isp ? (r & (SEQ - 1)) : ((r - MP) & 15), TT = isp ? SEQ : DS;
        const int ch = lane * 8;
        unsigned wq[3], wkv[2];
#pragma unroll
        for (int j = 0; j < 3; ++j) wq[j] = __builtin_nontemporal_load(&((const unsigned*)pr)[lane + 64 * j]);
#pragma unroll
        for (int j = 0; j < 2; ++j) wkv[j] = __builtin_nontemporal_load(&((const unsigned*)(pr + C_CKV))[lane + 64 * j]);
        const bf16_t rx1 = pr[C_KR + (lane & 15)], rx2 = pr[C_KR + 16 + (lane & 15)]; const f32x2 cs = ROPE_T[(size_t)tok_pos(r) * 16 + (lane & 15)];
        u32x4 cwv[4];
#pragma unroll
        for (int k = 0; k < 4; ++k) { const int tt = t - 3 + k; cwv[k] = (tt >= 0) ? *(const u32x4*)(pr + (ptrdiff_t)(k - 3) * NIN + C_RGX + ch) : (u32x4){0u, 0u, 0u, 0u}; }
        const u32x4 gw4 = __builtin_nontemporal_load((const u32x4*)(pr + C_RGG + ch));
        { float s = 0.f;
#pragma unroll
          for (int j = 0; j < 3; ++j) { const float lo = bflo(wq[j]), hi = bfhi(wq[j]); s += lo * lo + hi * hi; }
          const float rs = 1.0f / sqrtf(wave_sum(s) * (1.0f / QL) + EPS);
#pragma unroll
          for (int j = 0; j < 3; ++j) ((unsigned*)(CQN + (size_t)r * QL))[lane + 64 * j] = pk2(bflo(wq[j]) * rs, bfhi(wq[j]) * rs); }
        { float s = 0.f;
#pragma unroll
          for (int j = 0; j < 2; ++j) { const float lo = bflo(wkv[j]), hi = bfhi(wkv[j]); s += lo * lo + hi * hi; }
          const float rs = 1.0f / sqrtf(wave_sum(s) * (1.0f / KVL) + EPS);
          float* co = isp ? out + O_PCKV + (size_t)r * KVL : out + O_SCKV + (size_t)(r - MP) * KVL;
#pragma unroll
          for (int j = 0; j < 2; ++j) { const int e = 2 * (lane + 64 * j); const float v0 = bflo(wkv[j]) * rs * kvg[j][0], v1 = bfhi(wkv[j]) * rs * kvg[j][1];
              __builtin_nontemporal_store((f32x2){v0, v1}, (f32x2*)(co + e)); ((unsigned*)(CKVN + (size_t)r * KVL))[lane + 64 * j] = pk2(v0, v1); } }
        if (lane < 16) { const float x1 = bf2f(rx1), x2 = bf2f(rx2);
            const float o1 = x1 * cs[0] - x2 * cs[1], o2 = x2 * cs[0] + x1 * cs[1];
            float* ko = isp ? out + O_PKR + (size_t)r * ROPE : out + O_SKR + (size_t)(r - MP) * ROPE;
            ko[lane] = o1; ko[lane + 16] = o2;
            bf16_t* kr = KR + (size_t)r * ROPE; kr[lane] = (bf16_t)f2bf(o1); kr[lane + 16] = (bf16_t)f2bf(o2); }
        { float xk[4][8];
#pragma unroll
          for (int k = 0; k < 4; ++k) { const int tt = t - 3 + k; const u32x4 w = cwv[k];
              xk[k][0] = bflo(w.x); xk[k][1] = bfhi(w.x); xk[k][2] = bflo(w.y); xk[k][3] = bfhi(w.y); xk[k][4] = bflo(w.z); xk[k][5] = bfhi(w.z); xk[k][6] = bflo(w.w); xk[k][7] = bfhi(w.w);
              if (tt < 0 && !isp) { const float* sb = state_rg_conv + ((size_t)rb * 3 + (t + k)) * RGW + ch;
#pragma unroll
                  for (int e = 0; e < 8; ++e) xk[k][e] = sb[e]; } }
          float xo[8];
#pragma unroll
          for (int e = 0; e < 8; ++e) { float v = brg[e];
#pragma unroll
              for (int k = 0; k < 4; ++k) v += wrg[k][e] * xk[k][e];
              xo[e] = v; }
          u32x4 w; w.x = pk2(xo[0], xo[1]); w.y = pk2(xo[2], xo[3]); w.z = pk2(xo[4], xo[5]); w.w = pk2(xo[6], xo[7]);
          *(u32x4*)(XC + (size_t)r * RGW + ch) = w;
          u32x4 go; go.x = pk2(gelu_tanh(bflo(gw4.x)), gelu_tanh(bfhi(gw4.x))); go.y = pk2(gelu_tanh(bflo(gw4.y)), gelu_tanh(bfhi(gw4.y)));
          go.z = pk2(gelu_tanh(bflo(gw4.z)), gelu_tanh(bfhi(gw4.z))); go.w = pk2(gelu_tanh(bflo(gw4.w)), gelu_tanh(bfhi(gw4.w)));
          *(u32x4*)(GG + (size_t)r * RGW + ch) = go;
          if (t >= TT - 3) { float* so = (isp ? out + O_PRGC : out + O_SRGC) + ((size_t)rb * 3 + (t - (TT - 3))) * RGW + ch;
#pragma unroll
              for (int e = 0; e < 8; ++e) so[e] = xk[3][e]; } }
    }
    }
#endif
    GRID_BAR();

#if (PHMASK >> 3) & 1
    for (int rep_ = 0; rep_ <= ((DUPMASK >> 3) & 1); ++rep_)
    {
    PHASE_IDS();
    {
#if P3SEL & 1
        { pg8::Gemm g{CQN, WUQ, QL, QL}; pg8::StaticOrder S; S.init(MT, NQ, QL, G, bx); pg8::EpiQ E{QB, ROPE_T}; pg8::gemm_phase<pg8::EpiQ, pg8::StaticOrder>(ldsl, g, S, E); }
#endif
#if P3SEL & 2
        { pg8::Gemm g{CKVN, WKV, KVL, KVL}; pg8::StaticOrder S; S.init(MP, 1024, KVL, G, bx); pg8::EpiStore<false> E{KV, 1024}; pg8::gemm_phase<pg8::EpiStore<false>, pg8::StaticOrder>(ldsl, g, S, E); }
#endif
#if P3SEL & 4
        { pg8::Gemm g{XC, WRG, RGW, RGW}; pg8::RgOrder S; S.S.init(MT, 1024, RGW, G, bx); pg8::EpiRG E{XC, b_rg_a, b_rg_i, SP, (_Float16*)(ws + WS_LA), UB}; pg8::gemm_phase<pg8::EpiRG, pg8::RgOrder>(ldsl, g, S, E); }
#endif
    }
    }
#endif
    GRID_BAR();

#if (PHMASK >> 4) & 1
    for (int rep_ = 0; rep_ <= ((DUPMASK >> 4) & 1); ++rep_)
    {
    PHASE_IDS();
    for (int it = gw; it < NB * 64 * 8; it += NGW) {
        const int g8 = it & 7, c = (it >> 3) & 63, b = it >> 9; const int ch = g8 * 64 + lane; const size_t r0 = (size_t)b * SEQ + c * 128;
        float S = 0.f, h = 0.f;
#pragma unroll 16
        for (int t = 0; t < 128; ++t) { const float l = (float)LA[(r0 + t) * RGW + ch] * (1.0f / 256.0f), uu = bf2f(UB[(r0 + t) * RGW + ch]); S += l; h = fexp(l) * h + uu; }
        SA[(size_t)(b * 64 + c) * RGW + ch] = S; SU[(size_t)(b * 64 + c) * RGW + ch] = h;
    }
    }
#endif
    GRID_BAR();

#if (PHMASK >> 5) & 1
    for (int rep_ = 0; rep_ <= ((DUPMASK >> 5) & 1); ++rep_)
    {
    PHASE_IDS();
    {
        for (int rp3 = 0; rp3 < RG_REP; ++rp3)
        for (int it = gw; it < NB * 64 * 8 + DB * 8; it += NGW) {
            if (it < NB * 64 * 8) {
                const int g8 = it & 7, c = (it >> 3) & 63, b = it >> 9; const int ch = g8 * 64 + lane; const size_t r0 = (size_t)b * SEQ + c * 128;
                float h = 0.f;
#pragma unroll 8
                for (int j = 0; j < c; ++j) h = fexp(SA[(size_t)(b * 64 + j) * RGW + ch]) * h + SU[(size_t)(b * 64 + j) * RGW + ch];
                for (int tb = 0; tb < 128; tb += 16) {
                    float lv[16]; bf16_t uv[16], gv[16];
#pragma unroll
                    for (int k = 0; k < 16; ++k) { const size_t r = r0 + tb + k; lv[k] = (float)__builtin_nontemporal_load(&LA[r * RGW + ch]) * (1.0f / 256.0f); uv[k] = __builtin_nontemporal_load(&UB[r * RGW + ch]); gv[k] = __builtin_nontemporal_load(&GG[r * RGW + ch]); }
#pragma unroll
                    for (int k = 0; k < 16; ++k) { const size_t r = r0 + tb + k; h = fexp(lv[k]) * h + bf2f(uv[k]);
                        CAT[r * DM + 512 + ch] = (bf16_t)f2bf(h * bf2f(gv[k])); }
                }
                if (c == 63) out[O_PRGH + (size_t)b * RGW + ch] = h;
            } else {
                const int i2 = it - NB * 64 * 8; const int g8 = i2 & 7, b = i2 >> 3; const int ch = g8 * 64 + lane; const size_t r0 = (size_t)MP + b * DS;
                float h = state_rg_h[(size_t)b * RGW + ch];
                float lv[16]; bf16_t uv[16], gv[16];
#pragma unroll
                for (int k = 0; k < 16; ++k) { const size_t r = r0 + k; lv[k] = (float)__builtin_nontemporal_load(&LA[r * RGW + ch]) * (1.0f / 256.0f); uv[k] = __builtin_nontemporal_load(&UB[r * RGW + ch]); gv[k] = __builtin_nontemporal_load(&GG[r * RGW + ch]); }
#pragma unroll
                for (int k = 0; k < 16; ++k) { const size_t r = r0 + k; h = fexp(lv[k]) * h + bf2f(uv[k]);
                    CAT[r * DM + 512 + ch] = (bf16_t)f2bf(h * bf2f(gv[k])); }
                out[O_SRGH + (size_t)b * RGW + ch] = h;
            }
        }
        __syncthreads();
        for (int idx = vcu; idx < 1280; idx += G) {
            if (idx < 1024) {
                const int i = idx >> 8, v = idx & 255, bh = v >> 3, s = v & 7, b = bh >> 3, h = bh & 7;
                const int qb = (i == 0) ? 31 - s : (i == 1) ? 16 + s : (i == 2) ? 15 - s : s;
                const size_t q0 = (size_t)b * SEQ + (size_t)qb * 256, k0 = (size_t)b * SEQ;
                att::attn_unit<true>(QB + q0 * NQ + h * 96, KV + k0 * 1024 + h * 64, KR + k0 * ROPE, KV + k0 * 1024 + 512 + h * 64, CAT + q0 * DM + h * 64,
                               4 * qb + 4, 64 * (4 * qb + (wave >> 1) + 1), true, 256, (char*)lds);
            } else {
                const int v = idx - 1024;
                for (int rp2 = 0; rp2 < SAMPLE_REP; ++rp2)
                att::sample_unit(v >> 3, v & 7, QB, w_uk, cache_ckv, cache_krope, CKVN, KR, (float*)(ws + WS_PO), (float*)(ws + WS_PM), (float*)(ws + WS_PL), (char*)lds);
            }
        }
    }
    }
#endif
    GRID_BAR();

    {
    PHASE_IDS();
    {
        float* PO = (float*)(ws + WS_PO); const float* PM = (const float*)(ws + WS_PM); const float* PL = (const float*)(ws + WS_PL);
        LAS float* oc = (LAS float*)(ldsl + wave * 2048);
        for (int it = vcu; it < DB * 8; it += G) {
            const int b = it >> 3, h = it & 7;
            float ms[2][8], ls[2][8]; f32x4 po[2][8];
#pragma unroll
            for (int q = 0; q < 2; ++q) { const int R = h * 16 + 2 * wave + q;
#pragma unroll
                for (int sp = 0; sp < 8; ++sp) { ms[q][sp] = PM[((size_t)b * 8 + sp) * 128 + R]; ls[q][sp] = PL[((size_t)b * 8 + sp) * 128 + R];
                    po[q][sp] = *(const f32x4*)(PO + (((size_t)b * 8 + sp) * 128 + R) * 256 + lane * 4); } }
#pragma unroll
            for (int q = 0; q < 2; ++q) { float M = -1e30f;
#pragma unroll
                for (int sp = 0; sp < 8; ++sp) M = fmaxf(M, ms[q][sp]);
                float L = 0.f; f32x4 a = (f32x4){0.f, 0.f, 0.f, 0.f};
#pragma unroll
                for (int sp = 0; sp < 8; ++sp) { const float wsc = __builtin_amdgcn_exp2f(ms[q][sp] - M); L += wsc * ls[q][sp]; a = a + po[q][sp] * wsc; }
                *(LAS f32x4*)(oc + q * 256 + lane * 4) = a * (1.0f / L); }
            asm volatile("s_waitcnt lgkmcnt(0)" ::: "memory");
            float acc0 = 0.f, acc1 = 0.f;
#pragma unroll 4
            for (int r = 0; r < 256; r += 4) {
                float wv[4];
#pragma unroll
                for (int q = 0; q < 4; ++q) wv[q] = w_uv[((size_t)(r + q) * 8 + h) * 64 + lane];
                const f32x4 o0 = *(const LAS f32x4*)(oc + r), o1 = *(const LAS f32x4*)(oc + 256 + r);
                acc0 += (o0[0] * wv[0] + o0[1] * wv[1]) + (o0[2] * wv[2] + o0[3] * wv[3]);
                acc1 += (o1[0] * wv[0] + o1[1] * wv[1]) + (o1[2] * wv[2] + o1[3] * wv[3]);
            }
            CAT[((size_t)MP + (size_t)b * DS + 2 * wave) * DM + h * 64 + lane] = (bf16_t)f2bf(acc0);
            CAT[((size_t)MP + (size_t)b * DS + 2 * wave + 1) * DM + h * 64 + lane] = (bf16_t)f2bf(acc1);
            asm volatile("s_waitcnt lgkmcnt(0)" ::: "memory");
        }
    }
    }
    GRID_BAR();

#if (PHMASK >> 6) & 1
    for (int rep_ = 0; rep_ <= ((DUPMASK >> 6) & 1); ++rep_)
    {
    PHASE_IDS();
    {
        pg8::Gemm g{CAT, WOUT, DM, DM}; pg8::StaticOrder S; S.init(MT, DM, DM, G, bx);
        pg8::EpiRes<false> E{x_prompt, x_sample, Y, X1B, SSQ2};
        pg8::gemm_phase<pg8::EpiRes<false>, pg8::StaticOrder>(ldsl, g, S, E);
    }
    }
#endif
    GRID_BAR();

#if (PHMASK >> 7) & 1
    for (int rep_ = 0; rep_ <= ((DUPMASK >> 7) & 1); ++rep_)
    {
    PHASE_IDS();
    {
        pg8::Gemm g{X1B, WUP, DM, DM}; pg8::StaticOrder S; S.init(MT, FF2, DM, G, bx);
        pg8::EpiUp E{ACT, HT, UPS, SSQ2, w_ffn_conv, b_ffn_conv, (LAS float*)(ldsl + LDS_HALO)};
        pg8::gemm_phase<pg8::EpiUp, pg8::StaticOrder>(ldsl, g, S, E);
    }
    }
#endif
    GRID_BAR();

#if (PHMASK >> 8) & 1
    for (int rep_ = 0; rep_ <= ((DUPMASK >> 8) & 1); ++rep_)
    {
    PHASE_IDS();
    {
#pragma unroll 4
        for (unsigned i = gt; i < (size_t)128 * 2 * FF; i += NGT) {
            const int c = (int)(i % FF), ri = (int)(i / FF), pm = ri >> 1, k = ri & 1;
            const bool first = (pm & 31) == 0;
            const float* h0 = HT + ((size_t)pm * 4) * FF2; const float* hp = HT + ((size_t)(pm - 1) * 4) * FF2;
            float res[2];
#pragma unroll
            for (int hb = 0; hb < 2; ++hb) { const int cc = hb * FF + c;
                const float cur = h0[(size_t)k * FF2 + cc];
                const float p1 = (k == 1) ? h0[cc] : (first ? 0.f : hp[(size_t)3 * FF2 + cc]);
                const float p2 = first ? 0.f : ((k == 1) ? hp[(size_t)3 * FF2 + cc] : hp[(size_t)2 * FF2 + cc]);
                res[hb] = b_ffn_conv[cc] + w_ffn_conv[cc] * p2 + w_ffn_conv[FF2 + cc] * p1 + w_ffn_conv[2 * FF2 + cc] * cur; }
            ACT[((size_t)pm * 256 + k) * FF + c] = (bf16_t)f2bf(gelu_tanh(res[0]) * res[1]);
        }
#pragma unroll 2
        for (unsigned i = gt; i < (size_t)MS * FF; i += NGT) {
            const int c = (int)(i % FF), ri = (int)(i / FF), b = ri >> 4, t = ri & 15;
            float res[2];
#pragma unroll
            for (int hb = 0; hb < 2; ++hb) { const int cc = hb * FF + c; float v = b_ffn_conv[cc];
#pragma unroll
                for (int k = 0; k < 3; ++k) { const int idx = t + k;
                    const float xv = (idx < 2) ? state_ffn_conv[((size_t)b * 2 + idx) * FF2 + cc] : UPS[((size_t)b * DS + idx - 2) * FF2 + cc];
                    v += w_ffn_conv[k * FF2 + cc] * xv; }
                res[hb] = v; }
            ACT[((size_t)MP + ri) * FF + c] = (bf16_t)f2bf(gelu_tanh(res[0]) * res[1]);
        }
        for (unsigned i = gt; i < (size_t)NB * 2 * FF2; i += NGT) { const int cc = (int)(i % FF2), k = (int)((i / FF2) & 1), b = (int)(i / (2 * FF2));
            out[O_PFFC + i] = HT[((size_t)(b * 32 + 31) * 4 + 2 + k) * FF2 + cc]; }
        for (unsigned i = gt; i < (size_t)DB * 2 * FF2; i += NGT) { const int cc = (int)(i % FF2), k = (int)((i / FF2) & 1), b = (int)(i / (2 * FF2));
            out[O_SFFC + i] = UPS[((size_t)b * DS + 14 + k) * FF2 + cc]; }
    }
    }
#endif
    GRID_BAR();

#if (PHMASK >> 9) & 1
    for (int rep_ = 0; rep_ <= ((DUPMASK >> 9) & 1); ++rep_)
    {
    PHASE_IDS();
    {
        pg8::Gemm g{ACT, WDN, FF, FF}; pg8::DownOrder S; S.S.init(MP, DM, FF, G, bx);
        pg8::EpiDown E{Y, (float*)(ws + WS_PART), X1B};
        pg8::gemm_phase<pg8::EpiDown, pg8::DownOrder>(ldsl, g, S, E);
    }
    }
#endif
    GRID_BAR();

#if (PHMASK >> 10) & 1
    for (int rep_ = 0; rep_ <= ((DUPMASK >> 10) & 1); ++rep_)
    {
    PHASE_IDS();
    for (int r = gw; r < MT; r += NGW) {
        f32x4* yr = (f32x4*)(Y + (size_t)r * DM) + lane;
        f32x4 v[4]; float s = 0.f;
        if (r < MP) {
#pragma unroll
            for (int j = 0; j < 4; ++j) v[j] = __builtin_nontemporal_load(&yr[64 * j]);
        } else {
#pragma unroll
            for (int j = 0; j < 4; ++j) { const u32x2 w = ((const u32x2*)(X1B + (size_t)r * DM))[lane + 64 * j]; v[j] = (f32x4){bflo(w.x), bfhi(w.x), bflo(w.y), bfhi(w.y)}; }
        }
        if (r >= MP) {
            for (int ks = 0; ks < 11; ++ks) { const f32x4* pr = (const f32x4*)((float*)(ws + WS_PART) + ((size_t)ks * MS + (r - MP)) * DM) + lane;
#pragma unroll
                for (int j = 0; j < 4; ++j) v[j] = v[j] + pr[64 * j]; } }
#pragma unroll
        for (int j = 0; j < 4; ++j) s += (v[j][0] * v[j][0] + v[j][1] * v[j][1]) + (v[j][2] * v[j][2] + v[j][3] * v[j][3]);
        const float rs = 1.0f / sqrtf(wave_sum(s) * (1.0f / DM) + EPS);
#pragma unroll
        for (int j = 0; j < 4; ++j) { const f32x4 gv = ((const f32x4*)final_norm_g)[lane + 64 * j]; __builtin_nontemporal_store(v[j] * rs * gv, &yr[64 * j]); }
    }
    }
#endif
}

#undef ws
#undef out
#undef Y
extern "C" void kernel_launch(void* const* d_in, const int* in_sizes, int n_in, void* d_out, int out_size, void* d_ws, size_t ws_size, hipStream_t stream) {
    static int grid = 0;
    if (grid == 0) {
        if (n_in != 28 || ws_size < WS_END) { fprintf(stderr, "kernel_launch: unexpected n_in %d / ws_size %zu (need %zu)\n", n_in, ws_size, (size_t)WS_END); grid = -1; return; }
        int dev = 0, cus = 0, per_cu = 0;
        hipGetDevice(&dev); hipDeviceGetAttribute(&cus, hipDeviceAttributeMultiprocessorCount, dev);
        if (hipFuncSetAttribute((const void*)fwd_megakernel, hipFuncAttributeMaxDynamicSharedMemorySize, LDS_BYTES) != hipSuccess) { fprintf(stderr, "kernel_launch: hipFuncSetAttribute failed\n"); grid = -1; return; }
        hipOccupancyMaxActiveBlocksPerMultiprocessor(&per_cu, (const void*)fwd_megakernel, 512, LDS_BYTES);
        (void)hipGetLastError();
        if (per_cu < 1) per_cu = 1;
        grid = cus;
    }
    if (grid < 0) return;
    if (hipMemsetAsync((char*)d_ws + WS_BAR, 0, XCD_BAR_WORDS * 4, stream) != hipSuccess) { fprintf(stderr, "kernel_launch: memset failed\n"); return; }
    Args a{};
    for (int i = 0; i < 28; ++i) a.in[i] = (const float*)d_in[i];
    a.out = (float*)d_out; a.ws = (unsigned char*)d_ws;
    void* args[] = {&a};
    hipError_t e = hipLaunchCooperativeKernel((const void*)fwd_megakernel, dim3(grid), dim3(512), args, LDS_BYTES, stream);
    if (e != hipSuccess) fprintf(stderr, "cooperative launch failed: %s (grid %d)\n", hipGetErrorString(e), grid);
}
```
